# Optimizing an MI355X kernel written in HIP

```python
import jax, jax.numpy as jnp
from jax import lax
import numpy as np

D_MODEL = 1024
BATCH = 2
SEQ = 8192
DEPTH = 2

N_META = 16
D_MIX = D_MODEL
D_POOL = D_MIX // 4
POOL_WINDOWS = (2, 4, 8, 16)
POOL_GROUPS = len(POOL_WINDOWS)
POOL_GW = D_POOL // POOL_GROUPS
D_CONV = D_MIX // 4
CONV_K = 31
D_RNN = D_MIX - D_POOL - D_CONV
RG_HEADS = 8
RG_HD = D_RNN // RG_HEADS
RG_CONV_K = 4
RG_C = 8.0
D_IN = D_POOL + 2 * D_CONV + 2 * D_RNN
D_FF = 4 * D_MODEL
EPS = 1e-6

kernel_name = "hymba_pool_conformer_rglru_hybrid"


def _rmsnorm(x, g):
    xf = x.astype(jnp.float32)
    y = xf * lax.rsqrt(jnp.mean(xf * xf, axis=-1, keepdims=True) + EPS)
    return y.astype(x.dtype) * g


def _layernorm(x, g, b):
    xf = x.astype(jnp.float32)
    mu = jnp.mean(xf, axis=-1, keepdims=True)
    var = jnp.mean(jnp.square(xf - mu), axis=-1, keepdims=True)
    return ((xf - mu) * lax.rsqrt(var + EPS)).astype(x.dtype) * g + b


def _causal_depthwise_conv(x, w, b):
    K, C = w.shape
    y = lax.conv_general_dilated(
        x, w[:, None, :], window_strides=(1,), padding=[(K - 1, 0)],
        dimension_numbers=('NWC', 'WIO', 'NWC'), feature_group_count=C)
    return y + b


def _pool_mixer(u, w_grp, scale):
    B_, T, _ = u.shape
    uf = u.astype(jnp.float32)
    cs = jnp.cumsum(uf, axis=1)
    pos = jnp.arange(1, T + 1, dtype=jnp.int32)
    outs = []
    for g, w in enumerate(POOL_WINDOWS):
        sl = slice(g * POOL_GW, (g + 1) * POOL_GW)
        c = cs[..., sl]
        prev = jnp.pad(c, ((0, 0), (w, 0), (0, 0)))[:, :T]
        cnt = jnp.minimum(pos, w).astype(jnp.float32)[None, :, None]
        outs.append((c - prev) / cnt - uf[..., sl])
    pooled = jnp.stack(outs, axis=2).astype(u.dtype)
    mixed = jnp.einsum('btgc,gcd->btgd', pooled, w_grp).reshape(B_, T, D_POOL)
    return mixed * scale


def _conformer_conv(v, gt, w_dw, b_dw, ln_g, ln_b, w_pw):
    u = v * jax.nn.sigmoid(gt)
    u = _causal_depthwise_conv(u, w_dw, b_dw)
    u = jax.nn.silu(_layernorm(u, ln_g, ln_b))
    return u @ w_pw


def _linear_scan(a, b):
    def comb(l, r):
        return (l[0] * r[0], r[0] * l[1] + r[1])
    _, h = lax.associative_scan(comb, (a, b), axis=1)
    return h


def _rglru_branch(gate_in, x_in, conv_w, conv_b, w_a, b_a, w_x, b_x, lam):
    B_, T, _ = x_in.shape
    f32 = jnp.float32
    xc = _causal_depthwise_conv(x_in, conv_w, conv_b)
    xh = xc.reshape(B_, T, RG_HEADS, RG_HD)
    r = jax.nn.sigmoid((jnp.einsum('bthc,hcd->bthd', xh, w_a).reshape(B_, T, D_RNN) + b_a).astype(f32))
    i = jax.nn.sigmoid((jnp.einsum('bthc,hcd->bthd', xh, w_x).reshape(B_, T, D_RNN) + b_x).astype(f32))
    log_a = -RG_C * r * jax.nn.softplus(-lam.astype(f32))
    a = jnp.exp(log_a)
    mult = jnp.sqrt(-jnp.expm1(2.0 * log_a))
    h = _linear_scan(a, mult * (i * xc.astype(f32)))
    return (jax.nn.gelu(gate_in.astype(f32)) * h).astype(x_in.dtype)


def setup_inputs(seed: int = 0) -> dict:
    key = jax.random.key(seed)
    ks = jax.random.split(key, 24)
    f32 = jnp.float32
    L = DEPTH

    def nrm(k, shape, scale):
        return jax.random.normal(k, shape, f32) * scale

    u = jax.random.uniform(ks[15], (L, D_RNN), f32, 0.9, 0.999)
    a0 = u ** (1.0 / RG_C)
    rg_lambda = jnp.log(a0) - jnp.log1p(-a0)
    return {
        "x": nrm(ks[0], (BATCH, SEQ, D_MODEL), 1.0),
        "meta_tokens": nrm(ks[1], (N_META, D_MODEL), 1.0),
        "mix_norm_g": 1.0 + nrm(ks[2], (L, D_MODEL), 0.05),
        "w_in": nrm(ks[3], (L, D_MODEL, D_IN), D_MODEL ** -0.5),
        "pool_w": nrm(ks[4], (L, POOL_GROUPS, POOL_GW, POOL_GW), POOL_GW ** -0.5),
        "pool_scale": 1.0 + nrm(ks[5], (L, D_POOL), 0.1),
        "convb_dw_w": nrm(ks[6], (L, CONV_K, D_CONV), CONV_K ** -0.5),
        "convb_dw_b": nrm(ks[7], (L, D_CONV), 0.02),
        "convb_ln_g": 1.0 + nrm(ks[8], (L, D_CONV), 0.05),
        "convb_ln_b": nrm(ks[9], (L, D_CONV), 0.02),
        "convb_pw_w": nrm(ks[10], (L, D_CONV, D_CONV), D_CONV ** -0.5),
        "rg_conv_w": nrm(ks[11], (L, RG_CONV_K, D_RNN), RG_CONV_K ** -0.5),
        "rg_conv_b": nrm(ks[12], (L, D_RNN), 0.02),
        "rg_w_a": nrm(ks[13], (L, RG_HEADS, RG_HD, RG_HD), RG_HD ** -0.5),
        "rg_b_a": nrm(ks[14], (L, D_RNN), 0.02),
        "rg_w_x": nrm(ks[16], (L, RG_HEADS, RG_HD, RG_HD), RG_HD ** -0.5),
        "rg_b_x": nrm(ks[17], (L, D_RNN), 0.02),
        "rg_lambda": rg_lambda,
        "w_out": nrm(ks[18], (L, D_MIX, D_MODEL), D_MIX ** -0.5),
        "mlp_norm_g": 1.0 + nrm(ks[19], (L, D_MODEL), 0.05),
        "w_up": nrm(ks[20], (L, D_MODEL, D_FF), D_MODEL ** -0.5),
        "w_down": nrm(ks[21], (L, D_FF, D_MODEL), D_FF ** -0.5),
        "final_norm_g": 1.0 + nrm(ks[22], (D_MODEL,), 0.05),
    }


def reference(x, meta_tokens, mix_norm_g, w_in, pool_w, pool_scale, convb_dw_w, convb_dw_b,
              convb_ln_g, convb_ln_b, convb_pw_w, rg_conv_w, rg_conv_b, rg_w_a, rg_b_a,
              rg_w_x, rg_b_x, rg_lambda, w_out, mlp_norm_g, w_up, w_down, final_norm_g):
    B_ = x.shape[0]
    meta = jnp.broadcast_to(meta_tokens[None].astype(x.dtype), (B_, N_META, D_MODEL))
    h = jnp.concatenate([meta, x], axis=1)
    splits = [D_POOL, D_POOL + D_CONV, D_POOL + 2 * D_CONV, D_POOL + 2 * D_CONV + D_RNN]
    for l in range(DEPTH):
        u = _rmsnorm(h, mix_norm_g[l])
        p = u @ w_in[l]
        p_pool, p_bval, p_bgate, p_cgate, p_cx = jnp.split(p, splits, axis=-1)
        y_a = _pool_mixer(p_pool, pool_w[l], pool_scale[l])
        y_b = _conformer_conv(p_bval, p_bgate, convb_dw_w[l], convb_dw_b[l],
                              convb_ln_g[l], convb_ln_b[l], convb_pw_w[l])
        y_c = _rglru_branch(p_cgate, p_cx, rg_conv_w[l], rg_conv_b[l], rg_w_a[l], rg_b_a[l],
                            rg_w_x[l], rg_b_x[l], rg_lambda[l])
        y = jnp.concatenate([y_a, y_b, y_c], axis=-1)
        h = h + y @ w_out[l]
        u = _rmsnorm(h, mlp_norm_g[l])
        h = h + jnp.square(jax.nn.relu(u @ w_up[l])) @ w_down[l]
    h = _rmsnorm(h, final_norm_g)
    return h[:, N_META:]
```

```cpp
#include <hip/hip_runtime.h>
#include <hip/hip_cooperative_groups.h>
#include <cstdio>
#include <cstdint>
namespace cg = cooperative_groups;
namespace pg8 {
#define PG8_LAS __attribute__((address_space(3)))
typedef unsigned short bf16_t;
typedef short bf16x8 __attribute__((ext_vector_type(8)));
typedef float f32x4 __attribute__((ext_vector_type(4)));
typedef unsigned u32x4 __attribute__((ext_vector_type(4)));
constexpr int BM = 256, BK = 64, HALF = 128, HTB = HALF * BK * 2  , STAGE_BYTES = 8 * HTB, NXCD = 8, WGM = 8;

__host__ __device__ __forceinline__ int lds_byte(int r, int c) { const int st = (r >> 4) * 2 + (c >> 5), rr = r & 15, cc = c & 31, ob = rr * 64 + cc * 2; return st * 1024 + (ob ^ (((ob >> 9) & 1) << 5)); }
__host__ __device__ __forceinline__ void stage_rc(int b, int& R, int& C) { const int st = b / 1024, sb = b % 1024, swz = sb ^ (((sb >> 9) & 1) << 5); R = (st >> 1) * 16 + swz / 64; C = (st & 1) * 32 + (swz % 64) / 2; }
__host__ __device__ __forceinline__ int perm32(int rho) { const int n = rho >> 4, i = rho & 15; return 8 * (i >> 2) + 4 * n + (i & 3); }

__device__ __forceinline__ int opaque_tid() { int t = threadIdx.x; asm volatile("" : "+v"(t)); return t; }
struct Unit { int pm, pn; };
struct Gemm { const bf16_t* A; const bf16_t* Bt; int M, N, K; };

struct StaticOrder {
    int nM, nN, nwg, G, c;
    __host__ __device__ void init(int M, int N, int G_, int c_) { nM = M / BM; nN = N / BM; nwg = nM * nN; G = G_; c = c_; }
    __host__ __device__ bool next(int i, Unit& u) const {
        const long L = (long)i * G + c; if (L >= nwg) return false;
        int wgid = (int)L; { const int q = nwg / NXCD, r = nwg % NXCD, xcd = wgid % NXCD, off = wgid / NXCD; wgid = (xcd < r ? xcd * (q + 1) : r * (q + 1) + (xcd - r) * q) + off; }
        const int nig = WGM * nN, gid = wgid / nig, fm = gid * WGM, gsz = (nM - fm) < WGM ? (nM - fm) : WGM;
        u.pm = fm + ((wgid % nig) % gsz); u.pn = (wgid % nig) / gsz; return true;
    }
    __device__ __forceinline__ void a_ready(const Unit&) const {}
    __device__ __forceinline__ void done(const Unit&) const {}
};
__device__ __forceinline__ unsigned cvt_pk_bf16(float lo, float hi) { unsigned r; asm volatile("v_cvt_pk_bf16_f32 %0, %1, %2" : "=v"(r) : "v"(lo), "v"(hi)); return r; }
template <class Epi, class Sched, bool ALIGN_EPI = false, bool SP2 = false>
__device__ __forceinline__ void gemm_phase(PG8_LAS unsigned char* lds, const Gemm g, const Sched& S, const Epi& E) {
    const int tid = opaque_tid(), wid = __builtin_amdgcn_readfirstlane(tid >> 6), lane = tid & 63, wr = wid >> 2, wc = wid & 3, fr = lane & 15, fq = lane >> 4;
    const int K = g.K, nt = K / BK;
    unsigned voffA[2], voffB[2];
#pragma unroll
    for (int i = 0; i < 2; ++i) { int R, C; stage_rc(tid * 16 + i * 8192, R, C); const int Rb = Epi::PERM ? ((R & ~31) + perm32(R & 31)) : R;
        voffA[i] = (unsigned)(R * K + C) * 2u; voffB[i] = (unsigned)(Rb * K + C) * 2u; }
    const size_t kstep = (size_t)(BK * 2);
    const size_t hstep = (size_t)HALF * K * 2;
    const size_t tstep = 2 * hstep;
    const unsigned ldsw = (unsigned)wid * 1024u;
    const int aoff = lds_byte(wr * 64 + fr, fq * 8), boff = lds_byte(wc * 32 + fr, fq * 8);
#define PG8_SA(b, h) (((b) * 2 + (h)) * HTB)
#define PG8_SB(b, h) ((4 + (b) * 2 + (h)) * HTB)
#define PG8_STAGE(bufoff, gbase, voff) do { _Pragma("unroll") for (int _i = 0; _i < 2; ++_i) \
        __builtin_amdgcn_global_load_lds((const unsigned*)((const char*)(gbase) + (voff)[_i]), (PG8_LAS unsigned*)(lds + (bufoff) + ldsw + _i * 8192), 16, 0, 0); } while (0)
#define PG8_LDA(dst, b, h) do { _Pragma("unroll") for (int m = 0; m < 4; ++m) _Pragma("unroll") for (int k = 0; k < 2; ++k) dst[m][k] = *(const PG8_LAS bf16x8*)(lds + PG8_SA(b, h) + aoff + m * 2048 + k * 1024); } while (0)
#define PG8_LDB(dst, b, h) do { _Pragma("unroll") for (int n = 0; n < 2; ++n) _Pragma("unroll") for (int k = 0; k < 2; ++k) dst[n][k] = *(const PG8_LAS bf16x8*)(lds + PG8_SB(b, h) + boff + n * 2048 + k * 1024); } while (0)
#define PG8_MMA(ai, bj, At, Bt) do { __builtin_amdgcn_s_setprio(1); _Pragma("unroll") for (int m = 0; m < 4; ++m) _Pragma("unroll") for (int n = 0; n < 2; ++n) _Pragma("unroll") for (int k = 0; k < 2; ++k) \
        acc[ai][bj][m][n] = __builtin_amdgcn_mfma_f32_16x16x32_bf16(Bt[n][k], At[m][k], acc[ai][bj][m][n], 0, 0, 0); __builtin_amdgcn_s_setprio(0); } while (0)
#define PG8_WAIT_V(n) asm volatile("s_waitcnt vmcnt(" #n ")" ::: "memory")
#define PG8_WAIT_L(n) asm volatile("s_waitcnt lgkmcnt(" #n ")" ::: "memory")
#define PG8_BAR __builtin_amdgcn_s_barrier()
#define PG8_SCHED __builtin_amdgcn_sched_barrier(0)
    Unit cur, nxt; int ui = 0;
    if (!S.next(0, cur)) return;
    f32x4 acc[2][2][4][2];
#pragma unroll
    for (int a = 0; a < 2; ++a)
#pragma unroll
        for (int b = 0; b < 2; ++b)
#pragma unroll
            for (int m = 0; m < 4; ++m)
#pragma unroll
                for (int n = 0; n < 2; ++n) acc[a][b][m][n] = (f32x4){0.f, 0.f, 0.f, 0.f};
    bf16x8 At[4][2], B0[2][2], B1[2][2];
    const char* cA = (const char*)g.A + (size_t)cur.pm * tstep; const char* cB = (const char*)g.Bt + (size_t)cur.pn * tstep;
    S.a_ready(cur);
    if constexpr (SP2) {
        PG8_STAGE(PG8_SB(0, 0), cB, voffB); PG8_STAGE(PG8_SB(0, 1), cB + hstep, voffB); PG8_STAGE(PG8_SA(0, 0), cA, voffA); PG8_STAGE(PG8_SA(0, 1), cA + hstep, voffA);
        if (wr == 1) PG8_BAR;
        PG8_WAIT_V(2); PG8_BAR;
        PG8_STAGE(PG8_SB(1, 0), cB + kstep, voffB); PG8_STAGE(PG8_SA(1, 0), cA + kstep, voffA); PG8_STAGE(PG8_SB(1, 1), cB + hstep + kstep, voffB);
        PG8_WAIT_V(6); PG8_BAR;
    } else {
        PG8_STAGE(PG8_SB(0, 0), cB, voffB); PG8_STAGE(PG8_SA(0, 0), cA, voffA); PG8_STAGE(PG8_SB(0, 1), cB + hstep, voffB); PG8_STAGE(PG8_SA(0, 1), cA + hstep, voffA);
        if (wr == 1) PG8_BAR;
        PG8_WAIT_V(4); PG8_BAR;
        PG8_STAGE(PG8_SB(1, 0), cB + kstep, voffB); PG8_STAGE(PG8_SA(1, 0), cA + kstep, voffA); PG8_STAGE(PG8_SB(1, 1), cB + hstep + kstep, voffB);
        PG8_WAIT_V(6); PG8_BAR;
    }
    for (;;) {
        const bool has_next = S.next(ui + 1, nxt);
        const char* nA = has_next ? (const char*)g.A + (size_t)nxt.pm * tstep : cA; const char* nB = has_next ? (const char*)g.Bt + (size_t)nxt.pn * tstep : cB;
        for (int t = 0; t < nt; t += 2) {
            const bool last = (t == nt - 2);
            const char* a1 = cA + (size_t)(t + 1) * kstep;
            const char* a2 = last ? nA : cA + (size_t)(t + 2) * kstep; const char* b2 = last ? nB : cB + (size_t)(t + 2) * kstep;
            const char* a3 = a2 + kstep; const char* b3 = b2 + kstep;
            if (last && has_next) S.a_ready(nxt);
            if constexpr (SP2) {
            PG8_LDB(B0, 0, 0); PG8_LDB(B1, 0, 1); PG8_SCHED; PG8_LDA(At, 0, 0); PG8_STAGE(PG8_SA(1, 1), a1 + hstep, voffA);
            PG8_WAIT_V(8); PG8_WAIT_L(0); PG8_BAR; PG8_MMA(0, 0, At, B0); PG8_MMA(0, 1, At, B1); PG8_BAR; PG8_SCHED;
            PG8_LDA(At, 0, 1); PG8_STAGE(PG8_SB(0, 0), b2, voffB); PG8_STAGE(PG8_SB(0, 1), b2 + hstep, voffB); PG8_STAGE(PG8_SA(0, 0), a2, voffA);
            PG8_WAIT_V(8); PG8_WAIT_L(0); PG8_BAR; PG8_MMA(1, 0, At, B0); PG8_MMA(1, 1, At, B1); PG8_BAR; PG8_SCHED;
            PG8_LDB(B0, 1, 0); PG8_LDB(B1, 1, 1); PG8_SCHED; PG8_LDA(At, 1, 0); PG8_STAGE(PG8_SA(0, 1), a2 + hstep, voffA);
            PG8_WAIT_V(8); PG8_WAIT_L(0); PG8_BAR; PG8_MMA(0, 0, At, B0); PG8_MMA(0, 1, At, B1); PG8_BAR; PG8_SCHED;
            PG8_LDA(At, 1, 1); PG8_STAGE(PG8_SB(1, 0), b3, voffB); PG8_STAGE(PG8_SB(1, 1), b3 + hstep, voffB); PG8_STAGE(PG8_SA(1, 0), a3, voffA);
            PG8_WAIT_V(8); PG8_WAIT_L(0); PG8_BAR; PG8_MMA(1, 0, At, B0); PG8_MMA(1, 1, At, B1); PG8_BAR; PG8_SCHED;
            } else {
            PG8_LDB(B0, 0, 0); PG8_SCHED; PG8_LDA(At, 0, 0); PG8_STAGE(PG8_SA(1, 1), a1 + hstep, voffA);
            PG8_WAIT_L(8); PG8_BAR; PG8_WAIT_L(0); PG8_MMA(0, 0, At, B0); PG8_BAR; PG8_SCHED;
            PG8_LDB(B1, 0, 1); PG8_STAGE(PG8_SB(0, 0), b2, voffB);
            PG8_BAR; PG8_WAIT_L(0); PG8_MMA(0, 1, At, B1); PG8_BAR;
            PG8_LDA(At, 0, 1); PG8_STAGE(PG8_SA(0, 0), a2, voffA);
            PG8_BAR; PG8_WAIT_L(0); PG8_MMA(1, 0, At, B0); PG8_BAR; PG8_SCHED;
            PG8_STAGE(PG8_SB(0, 1), b2 + hstep, voffB);
            PG8_WAIT_V(6); PG8_BAR; PG8_MMA(1, 1, At, B1); PG8_BAR;
            PG8_LDB(B0, 1, 0); PG8_SCHED; PG8_LDA(At, 1, 0); PG8_STAGE(PG8_SA(0, 1), a2 + hstep, voffA);
            PG8_WAIT_L(8); PG8_BAR; PG8_WAIT_L(0); PG8_MMA(0, 0, At, B0); PG8_BAR; PG8_SCHED;
            PG8_LDB(B1, 1, 1); PG8_STAGE(PG8_SB(1, 0), b3, voffB);
            PG8_BAR; PG8_WAIT_L(0); PG8_MMA(0, 1, At, B1); PG8_BAR;
            PG8_LDA(At, 1, 1); PG8_STAGE(PG8_SA(1, 0), a3, voffA);
            PG8_BAR; PG8_WAIT_L(0); PG8_MMA(1, 0, At, B0); PG8_BAR; PG8_SCHED;
            PG8_STAGE(PG8_SB(1, 1), b3 + hstep, voffB);
            PG8_WAIT_V(6); PG8_BAR; PG8_MMA(1, 1, At, B1); PG8_BAR;
            }
        }
        if constexpr (ALIGN_EPI) { if (wr == 0) PG8_BAR; }
        if constexpr (!Epi::AFTER_DRAIN) { E(acc, cur, wr, wc, fr, fq); S.done(cur); }
        if (!has_next) break;
#pragma unroll
        for (int a = 0; a < 2; ++a)
#pragma unroll
            for (int b = 0; b < 2; ++b)
#pragma unroll
                for (int m = 0; m < 4; ++m)
#pragma unroll
                    for (int n = 0; n < 2; ++n) acc[a][b][m][n] = (f32x4){0.f, 0.f, 0.f, 0.f};
        cur = nxt; cA = nA; cB = nB; ++ui;
        if constexpr (ALIGN_EPI) { if (wr == 1) PG8_BAR; }
    }
    PG8_WAIT_V(0);
    if constexpr (!ALIGN_EPI) { if (wr == 0) PG8_BAR; }
    PG8_BAR;
    if constexpr (Epi::AFTER_DRAIN) { E.fused(acc, cur, wr, wc, fr, fq, lds, wid, lane); S.done(cur); }
#undef PG8_SA
#undef PG8_SB
#undef PG8_STAGE
#undef PG8_LDA
#undef PG8_LDB
#undef PG8_MMA
#undef PG8_WAIT_V
#undef PG8_WAIT_L
#undef PG8_BAR
#undef PG8_SCHED
}
}

#define LAS __attribute__((address_space(3)))
typedef unsigned short bf16;
typedef float f32x4 __attribute__((ext_vector_type(4)));
typedef float f32x2 __attribute__((ext_vector_type(2)));
typedef short bf16x8 __attribute__((ext_vector_type(8)));
typedef unsigned u32x4 __attribute__((ext_vector_type(4)));
typedef unsigned u32x2 __attribute__((ext_vector_type(2)));

constexpr int D = 1024, SEQ = 8192, NB = 2, NMETA = 16, MMAIN = NB * SEQ, MPAD = MMAIN + 256, DIN = 1792, DFF = 4096, NLAYER = 2;
constexpr int C_POOL = 0, C_BVAL = 256, C_BGATE = 512, C_CGATE = 768, C_CX = 1280;
constexpr int DRNN = 512, DCONV = 256, DPOOL = 256, CONVK = 31;
constexpr float EPS = 1e-6f;
constexpr int NWAVES = 8, NTHR = 512;

constexpr size_t MiB = 1u << 20;
constexpr size_t WS_PART = 1 * MiB;
constexpr size_t WS_AGG = 3 * MiB;
constexpr size_t WS_HMETA = 5 * MiB;
constexpr size_t WS_SMALLW = 6 * MiB;
constexpr size_t WS_WIN = 7 * MiB, WS_WOUT = 14 * MiB, WS_WUP = 18 * MiB, WS_WDN = 34 * MiB;
constexpr size_t WS_HB = 50 * MiB;
constexpr size_t WS_BIG = 83 * MiB;
constexpr size_t WS_P = WS_BIG, WS_Y = 140 * MiB, WS_GP = 173 * MiB, WS_END = 213 * MiB;
static_assert(WS_P + (size_t)MPAD * DIN * 2 <= WS_Y && WS_Y + (size_t)MPAD * D * 2 <= WS_GP && WS_GP + (size_t)MPAD * DRNN * 2 <= WS_END && WS_BIG + (size_t)MPAD * DFF * 2 <= WS_END, "ws map");
static_assert(WS_HB + (size_t)MPAD * D * 2 <= WS_BIG, "ws map hb");
constexpr size_t SMALLW_LAYER = 512 * 1024;
constexpr size_t SW_POOL = 0, SW_PW = 32 * 1024, SW_WA = 160 * 1024, SW_WX = 224 * 1024;
constexpr size_t AG_SP = 0, AG_SH = AG_SP + NB * 128 * 512, AG_TP = AG_SH + NB * 128 * 512, AG_TH = AG_TP + NB * 32 * 512, AG_MP = AG_TH + NB * 32 * 512, AG_MH = AG_MP + 512;

constexpr int LDS_BYTES = 147456;
constexpr int ASTRIDE = 544;
constexpr int L_PA = 0, L_CA = 64 * ASTRIDE, L_STATS = 2 * 64 * ASTRIDE;
constexpr int XSTRIDE = 144, L_XS = 0, L_CST = 8 * 64 * XSTRIDE, L_AGG = L_CST + 3 * 128 * 4;
static_assert(L_STATS + 1024 <= LDS_BYTES && L_AGG + 8 * 64 * 8 <= LDS_BYTES, "lds map");

__device__ __forceinline__ float bf_lo(unsigned u) { return __uint_as_float(u << 16); }
__device__ __forceinline__ float bf_hi(unsigned u) { return __uint_as_float(u & 0xffff0000u); }
__device__ __forceinline__ unsigned pk_bf16(float lo, float hi) { return pg8::cvt_pk_bf16(lo, hi); }
__device__ __forceinline__ float sigm(float x) { return __builtin_amdgcn_rcpf(1.0f + __expf(-x)); }
__device__ __forceinline__ float gelu_tanh(float x) { return x * sigm(1.5957691216f * (x + 0.044715f * x * x * x)); }
__device__ __forceinline__ float wave_sum(float v) {
#pragma unroll
    for (int o = 1; o < 64; o <<= 1) v += __shfl_xor(v, o);
    return v;
}
template <int N> __device__ __forceinline__ float dpp_shr(float old, float x) {
    return __builtin_bit_cast(float, __builtin_amdgcn_update_dpp(__builtin_bit_cast(int, old), __builtin_bit_cast(int, x), 0x110 + N, 0xF, 0xF, false));
}
__device__ __forceinline__ int row_of(int b, int q) { return q < NMETA ? MMAIN + q : b * SEQ + q - NMETA; }

struct Ctx {
    const float* in[23]; float* out; unsigned char* ws;
};

template <bool RELU2> struct EpiScale {
    static constexpr bool PERM = true, AFTER_DRAIN = false;
    bf16* O; int ldc; const float* part;
    __device__ __forceinline__ void operator()(const pg8::f32x4 (&acc)[2][2][4][2], const pg8::Unit& u, int wr, int wc, int fr, int fq) const {
        const int row0 = u.pm * 256 + wr * 64 + fr, col0 = u.pn * 256 + wc * 32 + 8 * fq;
        const int lane = fr + 16 * fq;
        float rsl[2];
#pragma unroll
        for (int ai = 0; ai < 2; ++ai) { const f32x4* pp = (const f32x4*)(part + (size_t)(u.pm * 256 + ai * 128 + wr * 64 + lane) * 16);
            const f32x4 s4 = (pp[0] + pp[1]) + (pp[2] + pp[3]);
            rsl[ai] = __builtin_amdgcn_rsqf(((s4.x + s4.y) + (s4.z + s4.w)) * (1.0f / D) + EPS); }
        asm volatile("" ::: "memory");
#pragma unroll
        for (int ai = 0; ai < 2; ++ai)
#pragma unroll
            for (int m = 0; m < 4; ++m) {
                const int row = row0 + ai * 128 + m * 16;
                const float rs = __shfl(rsl[ai], 16 * m + fr);
                bf16* rowp = O + (size_t)row * ldc + col0;
#pragma unroll
                for (int bj = 0; bj < 2; ++bj) {
                    f32x4 v0 = acc[ai][bj][m][0] * rs, v1 = acc[ai][bj][m][1] * rs;
                    if (RELU2) {
#pragma unroll
                        for (int j = 0; j < 4; ++j) { const float a0 = fmaxf(v0[j], 0.f), a1 = fmaxf(v1[j], 0.f); v0[j] = a0 * a0; v1[j] = a1 * a1; }
                    }
                    u32x4 w; w.x = pk_bf16(v0[0], v0[1]); w.y = pk_bf16(v0[2], v0[3]); w.z = pk_bf16(v1[0], v1[1]); w.w = pk_bf16(v1[2], v1[3]);
                    *(u32x4*)(rowp + bj * 128) = w;
                }
            }
    }
};
struct EpiResid {
    static constexpr bool PERM = true, AFTER_DRAIN = false;
    float* hmain; float* hmeta; bf16* hb; float* part;
    __device__ __forceinline__ void operator()(const pg8::f32x4 (&acc)[2][2][4][2], const pg8::Unit& u, int wr, int wc, int fr, int fq) const {
        const int row0 = u.pm * 256 + wr * 64 + fr, col0 = u.pn * 256 + wc * 32 + 8 * fq;
#pragma unroll
        for (int ai = 0; ai < 2; ++ai)
#pragma unroll
            for (int m = 0; m < 4; ++m) {
                const int row = row0 + ai * 128 + m * 16;
                float* hrow = (row < MMAIN ? hmain + (size_t)row * D : hmeta + (size_t)(row - MMAIN) * D) + col0;
                bf16* brow = hb + (size_t)row * D + col0;
                float ss = 0.f;
#pragma unroll
                for (int bj = 0; bj < 2; ++bj) {
                    const f32x4 r0 = *(const f32x4*)(hrow + bj * 128), r1 = *(const f32x4*)(hrow + bj * 128 + 4);
                    const f32x4 v0 = acc[ai][bj][m][0] + r0, v1 = acc[ai][bj][m][1] + r1;
                    *(f32x4*)(hrow + bj * 128) = v0; *(f32x4*)(hrow + bj * 128 + 4) = v1;
                    u32x4 w; w.x = pk_bf16(v0[0], v0[1]); w.y = pk_bf16(v0[2], v0[3]); w.z = pk_bf16(v1[0], v1[1]); w.w = pk_bf16(v1[2], v1[3]);
                    *(u32x4*)(brow + bj * 128) = w;
                    ss += (v0[0] * v0[0] + v0[1] * v0[1]) + (v0[2] * v0[2] + v0[3] * v0[3]) + (v1[0] * v1[0] + v1[1] * v1[1]) + (v1[2] * v1[2] + v1[3] * v1[3]);
                }
                ss += __shfl_xor(ss, 16); ss += __shfl_xor(ss, 32);
                if (fq == 0) part[(size_t)row * 16 + u.pn * 4 + wc] = ss;
                asm volatile("" ::: "memory");
            }
    }
};

__device__ __forceinline__ void p0_transpose_item(const float* W, int K, int N, bf16* WT, const float* gk, LAS float* scr, int item, int lane) {
    const int nblk = N / 32, kb = item / nblk, nb = item % nblk, k0 = 64 * kb, n0 = 32 * nb;
#pragma unroll 8
    for (int i = 0; i < 32; ++i) { const int kk = 2 * i + (lane >> 5); float v = W[(size_t)(k0 + kk) * N + n0 + (lane & 31)]; if (gk) v *= gk[k0 + kk]; scr[kk * 33 + (lane & 31)] = v; }
    asm volatile("s_waitcnt lgkmcnt(0)" ::: "memory");
    const int c = lane & 7;
#pragma unroll
    for (int j = 0; j < 4; ++j) { const int n = (lane >> 3) + 8 * j; const LAS float* s = scr + (8 * c) * 33 + n;
        u32x4 o; o.x = pk_bf16(s[0 * 33], s[1 * 33]); o.y = pk_bf16(s[2 * 33], s[3 * 33]); o.z = pk_bf16(s[4 * 33], s[5 * 33]); o.w = pk_bf16(s[6 * 33], s[7 * 33]);
        *(u32x4*)(WT + (size_t)(n0 + n) * K + k0 + 8 * c) = o; }
    asm volatile("s_waitcnt lgkmcnt(0)" ::: "memory");
}
__device__ __forceinline__ void p0_prologue(const Ctx& C, LAS unsigned char* lds) {
    const int tid = pg8::opaque_tid(), lane = tid & 63, wave = tid >> 6;
    LAS float* scr = (LAS float*)(lds + wave * 16384);
    const int gw = blockIdx.x * NWAVES + wave, NGW = gridDim.x * NWAVES;
    constexpr int I_IN = 16 * 56, I_OUT = 16 * 32, I_UP = 16 * 128, I_DN = 64 * 32, I_POOL = 4 * 2, I_PW = 4 * 8, I_WA = 8 * 2, I_WX = 8 * 2;
    constexpr int I_LAYER = I_IN + I_OUT + I_UP + I_DN + I_POOL + I_PW + I_WA + I_WX;
    unsigned char* ws = C.ws;
    for (int it = gw; it < NLAYER * I_LAYER; it += NGW) {
        const int l = it / I_LAYER; int r = it % I_LAYER;
        bf16* sw = (bf16*)(ws + WS_SMALLW + l * SMALLW_LAYER);
        if (r < I_IN) { p0_transpose_item(C.in[3] + (size_t)l * D * DIN, D, DIN, (bf16*)(ws + WS_WIN) + (size_t)l * D * DIN, C.in[2] + l * D, scr, r, lane); continue; } r -= I_IN;
        if (r < I_OUT) { p0_transpose_item(C.in[18] + (size_t)l * D * D, D, D, (bf16*)(ws + WS_WOUT) + (size_t)l * D * D, nullptr, scr, r, lane); continue; } r -= I_OUT;
        if (r < I_UP) { p0_transpose_item(C.in[20] + (size_t)l * D * DFF, D, DFF, (bf16*)(ws + WS_WUP) + (size_t)l * D * DFF, C.in[19] + l * D, scr, r, lane); continue; } r -= I_UP;
        if (r < I_DN) { p0_transpose_item(C.in[21] + (size_t)l * DFF * D, DFF, D, (bf16*)(ws + WS_WDN) + (size_t)l * DFF * D, nullptr, scr, r, lane); continue; } r -= I_DN;
        if (r < I_POOL) { const int g = r >> 1; p0_transpose_item(C.in[4] + (size_t)(l * 4 + g) * 4096, 64, 64, sw + SW_POOL / 2 + g * 4096, nullptr, scr, r & 1, lane); continue; } r -= I_POOL;
        if (r < I_PW) { p0_transpose_item(C.in[10] + (size_t)l * 65536, 256, 256, sw + SW_PW / 2, nullptr, scr, r, lane); continue; } r -= I_PW;
        if (r < I_WA) { const int h = r >> 1; p0_transpose_item(C.in[13] + (size_t)(l * 8 + h) * 4096, 64, 64, sw + SW_WA / 2 + h * 4096, nullptr, scr, r & 1, lane); continue; } r -= I_WA;
        { const int h = r >> 1; p0_transpose_item(C.in[15] + (size_t)(l * 8 + h) * 4096, 64, 64, sw + SW_WX / 2 + h * 4096, nullptr, scr, r & 1, lane); }
    }
    bf16* hb = (bf16*)(ws + WS_HB); float* part = (float*)(ws + WS_PART); float* hmeta = (float*)(ws + WS_HMETA);
    for (int m = gw; m < MPAD; m += NGW) {
        f32x4 v[4];
        const float* src = m < MMAIN ? C.in[0] + (size_t)m * D : (m < MMAIN + NMETA ? C.in[1] + (size_t)(m - MMAIN) * D : nullptr);
        float* dst = m < MMAIN ? C.out + (size_t)m * D : hmeta + (size_t)(m - MMAIN) * D;
        float s = 0.f;
#pragma unroll
        for (int j = 0; j < 4; ++j) { v[j] = src ? ((const f32x4*)src)[lane + 64 * j] : (f32x4){0.f, 0.f, 0.f, 0.f}; s += (v[j].x * v[j].x + v[j].y * v[j].y) + (v[j].z * v[j].z + v[j].w * v[j].w); }
        s = wave_sum(s);
#pragma unroll
        for (int j = 0; j < 4; ++j) { ((f32x4*)dst)[lane + 64 * j] = v[j];
            u32x2 w; w.x = pk_bf16(v[j].x, v[j].y); w.y = pk_bf16(v[j].z, v[j].w); ((u32x2*)(hb + (size_t)m * D))[lane + 64 * j] = w; }
        if (lane < 16) part[(size_t)m * 16 + lane] = lane == 0 ? s : 0.f;
    }
}

__device__ __forceinline__ void convpool_item(const Ctx& C, int l, int b, int pos0, int nvalid, LAS unsigned char* lds) {
    const int tid = pg8::opaque_tid(), lane = tid & 63, wid = __builtin_amdgcn_readfirstlane(tid >> 6), fr = lane & 15, fq = lane >> 4;
    const int cp = (wid & 1) * 64 + lane, tg = wid >> 1;
    const bf16* P = (const bf16*)(C.ws + WS_P); bf16* Y = (bf16*)(C.ws + WS_Y);
    const bf16* sw = (const bf16*)(C.ws + WS_SMALLW + l * SMALLW_LAYER);
#ifndef NO_POOLV
    {
        const int g = wid & 3, th = wid >> 2, ch = 64 * g + lane;
        float xr[47];
#pragma unroll
        for (int i = 0; i < 47; ++i) { const int q = pos0 + th * 32 - 15 + i; const unsigned v = *(const unsigned short*)(P + (size_t)row_of(b, max(q, 0)) * DIN + C_POOL + ch); xr[i] = q >= 0 ? __uint_as_float(v << 16) : 0.f; }
#define POOL_BODY(W) do { float sum = 0.f; \
        _Pragma("unroll") for (int d = 1; d < (W); ++d) sum += xr[15 - d]; \
        _Pragma("unroll") for (int j = 0; j < 32; ++j) { const int i = j + 15; sum += xr[i]; \
            const int q = pos0 + th * 32 + j; const float inv = 1.0f / (float)min(q + 1, (W)); const float o = sum * inv - xr[i]; \
            *(LAS unsigned short*)(lds + L_PA + (th * 32 + j) * ASTRIDE + ch * 2) = (unsigned short)(pk_bf16(o, 0.f) & 0xffffu); \
            sum -= xr[i - (W) + 1]; } } while (0)
        if (g == 0) POOL_BODY(2); else if (g == 1) POOL_BODY(4); else if (g == 2) POOL_BODY(8); else POOL_BODY(16);
#undef POOL_BODY
    }
#endif
#ifndef NO_CONVV
    {
        const float* dww = C.in[6] + (size_t)l * CONVK * DCONV + 2 * cp;
        f32x2 wk[CONVK];
#pragma unroll
        for (int k = 0; k < CONVK; ++k) wk[k] = *(const f32x2*)(dww + k * DCONV);
        const f32x2 bias = *(const f32x2*)(C.in[7] + l * DCONV + 2 * cp);
        f32x2 acc[16];
#pragma unroll
        for (int j = 0; j < 16; ++j) acc[j] = bias;
        unsigned rv[2][8], rg[2][8];
#define CONV_LOAD(c, buf) do { _Pragma("unroll") for (int ii = 0; ii < 8; ++ii) { const int i = (c) * 8 + ii; const int q = pos0 + tg * 16 - 30 + i; rv[buf][ii] = 0u; rg[buf][ii] = 0u; \
            if (i < 46) { const bf16* rp = P + (size_t)row_of(b, max(q, 0)) * DIN + 2 * cp; const unsigned t0 = *(const unsigned*)(rp + C_BVAL), t1 = *(const unsigned*)(rp + C_BGATE); rv[buf][ii] = q >= 0 ? t0 : 0u; rg[buf][ii] = t1; } } } while (0)
        CONV_LOAD(0, 0);
#pragma unroll
        for (int c = 0; c < 6; ++c) {
            asm volatile("" ::: "memory");
            if (c + 1 < 6) { if ((c & 1) == 0) CONV_LOAD(c + 1, 1); else CONV_LOAD(c + 1, 0); }
            asm volatile("" ::: "memory");
#pragma unroll
            for (int ii = 0; ii < 8; ++ii) { const int i = c * 8 + ii;
                if (i < 46) { const unsigned vv = rv[c & 1][ii], gg = rg[c & 1][ii];
                    const f32x2 u = (f32x2){bf_lo(vv) * sigm(bf_lo(gg)), bf_hi(vv) * sigm(bf_hi(gg))};
#pragma unroll
                    for (int j = 0; j < 16; ++j) { const int k = i - j; if (k >= 0 && k < CONVK) acc[j] += wk[k] * u; } } }
        }
#undef CONV_LOAD
#pragma unroll
        for (int j = 0; j < 16; ++j) {
            const float s1 = wave_sum(acc[j].x + acc[j].y), sq = wave_sum(acc[j].x * acc[j].x + acc[j].y * acc[j].y);
            if (lane == 0) *(LAS f32x2*)(lds + L_STATS + ((tg * 16 + j) * 2 + (wid & 1)) * 8) = (f32x2){s1, sq};
        }
        __syncthreads();
        const f32x2 lg = *(const f32x2*)(C.in[8] + l * DCONV + 2 * cp), lb = *(const f32x2*)(C.in[9] + l * DCONV + 2 * cp);
#pragma unroll
        for (int j = 0; j < 16; ++j) {
            const f32x4 st = *(LAS f32x4*)(lds + L_STATS + (tg * 16 + j) * 16);
            const float mean = (st.x + st.z) * (1.0f / DCONV), var = fmaxf((st.y + st.w) * (1.0f / DCONV) - mean * mean, 0.f), rstd = __builtin_amdgcn_rsqf(var + EPS);
            f32x2 y = (acc[j] - mean) * rstd * lg + lb;
            y.x = y.x * sigm(y.x); y.y = y.y * sigm(y.y);
            *(LAS unsigned*)(lds + L_CA + (tg * 16 + j) * ASTRIDE + cp * 4) = pk_bf16(y.x, y.y);
        }
        __syncthreads();
    }
#endif
#ifndef NO_CPMM
    {
        const int n0 = 32 * wid;
        pg8::f32x4 accb[4][2], acca[4][2];
#pragma unroll
        for (int m = 0; m < 4; ++m)
#pragma unroll
            for (int n = 0; n < 2; ++n) { accb[m][n] = (pg8::f32x4){0.f, 0.f, 0.f, 0.f}; acca[m][n] = (pg8::f32x4){0.f, 0.f, 0.f, 0.f}; }
        const bf16* pwt = sw + SW_PW / 2;
#pragma unroll
        for (int kk = 0; kk < 8; ++kk) {
            bf16x8 Bf[2];
#pragma unroll
            for (int n = 0; n < 2; ++n) Bf[n] = *(const bf16x8*)(pwt + (size_t)(n0 + 16 * n + fr) * 256 + 32 * kk + 8 * fq);
#pragma unroll
            for (int m = 0; m < 4; ++m) { const bf16x8 Af = *(const LAS bf16x8*)(lds + L_CA + (16 * m + fr) * ASTRIDE + (32 * kk + 8 * fq) * 2);
#pragma unroll
                for (int n = 0; n < 2; ++n) accb[m][n] = __builtin_amdgcn_mfma_f32_16x16x32_bf16(Bf[n], Af, accb[m][n], 0, 0, 0); }
        }
        const int g = wid >> 1, d0 = n0 & 63;
        const bf16* plt = sw + SW_POOL / 2 + g * 4096;
#pragma unroll
        for (int kk = 0; kk < 2; ++kk) {
            bf16x8 Bf[2];
#pragma unroll
            for (int n = 0; n < 2; ++n) Bf[n] = *(const bf16x8*)(plt + (size_t)(d0 + 16 * n + fr) * 64 + 32 * kk + 8 * fq);
#pragma unroll
            for (int m = 0; m < 4; ++m) { const bf16x8 Af = *(const LAS bf16x8*)(lds + L_PA + (16 * m + fr) * ASTRIDE + (64 * g + 32 * kk + 8 * fq) * 2);
#pragma unroll
                for (int n = 0; n < 2; ++n) acca[m][n] = __builtin_amdgcn_mfma_f32_16x16x32_bf16(Bf[n], Af, acca[m][n], 0, 0, 0); }
        }
        const float* psc = C.in[5] + l * DPOOL;
#pragma unroll
        for (int m = 0; m < 4; ++m) { const int tok = 16 * m + fr;
            if (tok < nvalid) { bf16* yr = Y + (size_t)row_of(b, pos0 + tok) * D;
#pragma unroll
                for (int n = 0; n < 2; ++n) { const int col = n0 + 16 * n + 4 * fq; const f32x4 sc = *(const f32x4*)(psc + col);
                    const pg8::f32x4 a = acca[m][n], c = accb[m][n];
                    u32x2 wa; wa.x = pk_bf16(a[0] * sc.x, a[1] * sc.y); wa.y = pk_bf16(a[2] * sc.z, a[3] * sc.w);
                    u32x2 wb; wb.x = pk_bf16(c[0], c[1]); wb.y = pk_bf16(c[2], c[3]);
                    *(u32x2*)(yr + col) = wa; *(u32x2*)(yr + DPOOL + col) = wb; } } }
    }
#endif
    __syncthreads();
}

__device__ __forceinline__ void rg_item(const Ctx& C, int l, int b, int pos0, int nvalid, int hp, int tile, LAS unsigned char* lds) {
    const int tid = pg8::opaque_tid(), lane = tid & 63, wid = __builtin_amdgcn_readfirstlane(tid >> 6), fr = lane & 15, fq = lane >> 4;
    const int hsel = wid & 1, s = wid >> 1, hh = 2 * hp + hsel, cb = 64 * hh, q0 = pos0 + 64 * s;
    const bf16* P = (const bf16*)(C.ws + WS_P); bf16* Y = (bf16*)(C.ws + WS_Y); bf16* GPb = (bf16*)(C.ws + WS_GP);
    const bf16* sw = (const bf16*)(C.ws + WS_SMALLW + l * SMALLW_LAYER);
    float* agg = (float*)(C.ws + WS_AGG);
    LAS float* cst = (LAS float*)(lds + L_CST);
    if (tid < 128) { const int c = 128 * hp + tid; cst[tid] = C.in[14][l * DRNN + c]; cst[128 + tid] = C.in[16][l * DRNN + c]; cst[256 + tid] = 8.0f * log1pf(__expf(-C.in[17][l * DRNN + c])); }
    LAS unsigned char* xs = lds + L_XS + wid * 64 * XSTRIDE;
#pragma unroll
    for (int kk = 0; kk < 2; ++kk) {
        const int cx = cb + 32 * kk + 8 * fq;
        f32x4 wk[4][2];
#pragma unroll
        for (int k = 0; k < 4; ++k) { wk[k][0] = *(const f32x4*)(C.in[11] + (size_t)(l * 4 + k) * DRNN + cx); wk[k][1] = *(const f32x4*)(C.in[11] + (size_t)(l * 4 + k) * DRNN + cx + 4); }
        const f32x4 bs0 = *(const f32x4*)(C.in[12] + l * DRNN + cx), bs1 = *(const f32x4*)(C.in[12] + l * DRNN + cx + 4);
#pragma unroll
        for (int m = 0; m < 4; ++m) {
            const int q = q0 + 16 * m + fr;
            f32x4 a0 = bs0, a1 = bs1;
#pragma unroll
            for (int k = 0; k < 4; ++k) { const int qq = q - 3 + k; u32x4 raw = (u32x4){0u, 0u, 0u, 0u};
                if (qq >= 0) raw = *(const u32x4*)(P + (size_t)row_of(b, qq) * DIN + C_CX + cx);
                a0 += wk[k][0] * (f32x4){bf_lo(raw.x), bf_hi(raw.x), bf_lo(raw.y), bf_hi(raw.y)};
                a1 += wk[k][1] * (f32x4){bf_lo(raw.z), bf_hi(raw.z), bf_lo(raw.w), bf_hi(raw.w)}; }
            u32x4 pk; pk.x = pk_bf16(a0.x, a0.y); pk.y = pk_bf16(a0.z, a0.w); pk.z = pk_bf16(a1.x, a1.y); pk.w = pk_bf16(a1.z, a1.w);
            *(LAS u32x4*)(xs + (16 * m + fr) * XSTRIDE + (32 * kk + 8 * fq) * 2) = pk;
        }
    }
    bf16x8 Ba[4][2], Bx[4][2];
#pragma unroll
    for (int n = 0; n < 4; ++n)
#pragma unroll
        for (int kk = 0; kk < 2; ++kk) { const size_t o = (size_t)(hh * 64 + 16 * n + fr) * 64 + 32 * kk + 8 * fq;
            Ba[n][kk] = *(const bf16x8*)(sw + SW_WA / 2 + o); Bx[n][kk] = *(const bf16x8*)(sw + SW_WX / 2 + o); }
    __syncthreads();
    f32x4 cP[4], cH[4];
#pragma unroll
    for (int n = 0; n < 4; ++n) { cP[n] = (f32x4){1.f, 1.f, 1.f, 1.f}; cH[n] = (f32x4){0.f, 0.f, 0.f, 0.f}; }
    const int bsrc = (lane & 48) | 15;
#pragma unroll 1
    for (int m = 0; m < 4; ++m) {
        pg8::f32x4 ga[4], gx[4];
        bf16x8 Af[2];
#pragma unroll
        for (int kk = 0; kk < 2; ++kk) Af[kk] = *(const LAS bf16x8*)(xs + (16 * m + fr) * XSTRIDE + (32 * kk + 8 * fq) * 2);
#pragma unroll
        for (int n = 0; n < 4; ++n) { ga[n] = (pg8::f32x4){0.f, 0.f, 0.f, 0.f}; gx[n] = (pg8::f32x4){0.f, 0.f, 0.f, 0.f};
#pragma unroll
            for (int kk = 0; kk < 2; ++kk) { ga[n] = __builtin_amdgcn_mfma_f32_16x16x32_bf16(Ba[n][kk], Af[kk], ga[n], 0, 0, 0); gx[n] = __builtin_amdgcn_mfma_f32_16x16x32_bf16(Bx[n][kk], Af[kk], gx[n], 0, 0, 0); } }
        const int tok = 64 * s + 16 * m + fr; const bool valid = tok < nvalid;
        const size_t row = valid ? (size_t)row_of(b, pos0 + tok) : 0;
#pragma unroll
        for (int n = 0; n < 4; ++n) {
            const int c0 = 16 * n + 4 * fq, cl = hsel * 64 + c0;
            const f32x4 ba = *(const LAS f32x4*)(cst + cl), bx = *(const LAS f32x4*)(cst + 128 + cl), sp = *(const LAS f32x4*)(cst + 256 + cl);
            const u32x2 xr = *(const LAS u32x2*)(xs + (16 * m + fr) * XSTRIDE + c0 * 2);
            const f32x4 xc = (f32x4){bf_lo(xr.x), bf_hi(xr.x), bf_lo(xr.y), bf_hi(xr.y)};
            u32x2 graw = (u32x2){0u, 0u};
            if (valid) graw = *(const u32x2*)(P + row * DIN + C_CGATE + cb + c0);
            const f32x4 gt = (f32x4){bf_lo(graw.x), bf_hi(graw.x), bf_lo(graw.y), bf_hi(graw.y)};
            f32x4 Pt, Ht;
#pragma unroll
            for (int v = 0; v < 4; ++v) {
                const float r = sigm(ga[n][v] + ba[v]), ig = sigm(gx[n][v] + bx[v]);
                const float la = -r * sp[v]; float a = __expf(la);
                const float x2 = 2.0f * la;
                const float om = x2 > -0.25f ? -x2 * (1.0f + x2 * (0.5f + x2 * (0.16666667f + x2 * (0.041666667f + x2 * (0.0083333333f + x2 * 0.0013888889f))))) : 1.0f - __expf(x2);
                float bb = __builtin_amdgcn_sqrtf(om) * ig * xc[v];
                if (!valid) { a = 1.0f; bb = 0.0f; }
                { float ap = dpp_shr<1>(1.0f, a), bp = dpp_shr<1>(0.0f, bb); bb = bb + a * bp; a = a * ap; }
                { float ap = dpp_shr<2>(1.0f, a), bp = dpp_shr<2>(0.0f, bb); bb = bb + a * bp; a = a * ap; }
                { float ap = dpp_shr<4>(1.0f, a), bp = dpp_shr<4>(0.0f, bb); bb = bb + a * bp; a = a * ap; }
                { float ap = dpp_shr<8>(1.0f, a), bp = dpp_shr<8>(0.0f, bb); bb = bb + a * bp; a = a * ap; }
                Pt[v] = a * cP[n][v]; Ht[v] = bb + a * cH[n][v];
            }
            if (valid) {
                f32x4 G;
#pragma unroll
                for (int v = 0; v < 4; ++v) G[v] = gelu_tanh(gt[v]);
                u32x2 w1; w1.x = pk_bf16(G[0] * Ht[0], G[1] * Ht[1]); w1.y = pk_bf16(G[2] * Ht[2], G[3] * Ht[3]);
                u32x2 w2; w2.x = pk_bf16(G[0] * Pt[0], G[1] * Pt[1]); w2.y = pk_bf16(G[2] * Pt[2], G[3] * Pt[3]);
                *(u32x2*)(Y + row * D + 512 + cb + c0) = w1; *(u32x2*)(GPb + row * DRNN + cb + c0) = w2;
            }
#pragma unroll
            for (int v = 0; v < 4; ++v) { cP[n][v] = __shfl(Pt[v], bsrc); cH[n][v] = __shfl(Ht[v], bsrc); }
        }
    }
    LAS float* aggL = (LAS float*)(lds + L_AGG);
    if (fr == 0) {
#pragma unroll
        for (int n = 0; n < 4; ++n)
#pragma unroll
            for (int v = 0; v < 4; ++v) { const int c0 = 16 * n + 4 * fq + v; aggL[(wid * 64 + c0) * 2] = cP[n][v]; aggL[(wid * 64 + c0) * 2 + 1] = cH[n][v]; }
        if (tile >= 0) { const size_t o = ((size_t)b * 128 + tile * 4 + s) * 512 + cb;
#pragma unroll
            for (int n = 0; n < 4; ++n) { *(f32x4*)(agg + AG_SP + o + 16 * n + 4 * fq) = cP[n]; *(f32x4*)(agg + AG_SH + o + 16 * n + 4 * fq) = cH[n]; } }
    }
    __syncthreads();
    if (wid < 2) {
        float Pt = 1.f, Ht = 0.f;
#pragma unroll
        for (int ss = 0; ss < 4; ++ss) { const f32x2 e = *(const LAS f32x2*)(aggL + (((ss * 2 + wid) * 64) + lane) * 2); Ht = e.y + e.x * Ht; Pt *= e.x; }
        if (tile >= 0) { const size_t o = ((size_t)b * 32 + tile) * 512 + cb + lane; agg[AG_TP + o] = Pt; agg[AG_TH + o] = Ht; }
        else { agg[AG_MP + cb + lane] = Pt; agg[AG_MH + cb + lane] = Ht; }
    }
    __syncthreads();
}

__device__ __forceinline__ void rg_fix_item(const Ctx& C, int b, int tile, int hp) {
    const int tid = pg8::opaque_tid(), lane = tid & 63, wid = __builtin_amdgcn_readfirstlane(tid >> 6);
    const int hsel = wid & 1, s = wid >> 1, c = 64 * (2 * hp + hsel) + 8 * (lane & 7), r8 = lane >> 3;
    bf16* Y = (bf16*)(C.ws + WS_Y); const bf16* GPb = (const bf16*)(C.ws + WS_GP); const float* agg = (const float*)(C.ws + WS_AGG);
    f32x4 H0 = *(const f32x4*)(agg + AG_MH + c), H1 = *(const f32x4*)(agg + AG_MH + c + 4);
#pragma unroll 4
    for (int jj = 0; jj < tile; ++jj) { const size_t o = ((size_t)b * 32 + jj) * 512 + c;
        const f32x4 p0 = *(const f32x4*)(agg + AG_TP + o), p1 = *(const f32x4*)(agg + AG_TP + o + 4), h0 = *(const f32x4*)(agg + AG_TH + o), h1 = *(const f32x4*)(agg + AG_TH + o + 4);
        H0 = h0 + p0 * H0; H1 = h1 + p1 * H1; }
    for (int ss = 0; ss < s; ++ss) { const size_t o = ((size_t)b * 128 + tile * 4 + ss) * 512 + c;
        const f32x4 p0 = *(const f32x4*)(agg + AG_SP + o), p1 = *(const f32x4*)(agg + AG_SP + o + 4), h0 = *(const f32x4*)(agg + AG_SH + o), h1 = *(const f32x4*)(agg + AG_SH + o + 4);
        H0 = h0 + p0 * H0; H1 = h1 + p1 * H1; }
#pragma unroll 4
    for (int it = 0; it < 8; ++it) {
        const size_t row = (size_t)b * SEQ + tile * 256 + 64 * s + 8 * it + r8;
        const u32x4 gh = *(const u32x4*)(Y + row * D + 512 + c), gp = *(const u32x4*)(GPb + row * DRNN + c);
        u32x4 o;
        o.x = pk_bf16(bf_lo(gh.x) + bf_lo(gp.x) * H0.x, bf_hi(gh.x) + bf_hi(gp.x) * H0.y);
        o.y = pk_bf16(bf_lo(gh.y) + bf_lo(gp.y) * H0.z, bf_hi(gh.y) + bf_hi(gp.y) * H0.w);
        o.z = pk_bf16(bf_lo(gh.z) + bf_lo(gp.z) * H1.x, bf_hi(gh.z) + bf_hi(gp.z) * H1.y);
        o.w = pk_bf16(bf_lo(gh.w) + bf_lo(gp.w) * H1.z, bf_hi(gh.w) + bf_hi(gp.w) * H1.w);
        *(u32x4*)(Y + row * D + 512 + c) = o;
    }
}

__device__ __forceinline__ void final_norm(const Ctx& C) {
    const int tid = pg8::opaque_tid(), lane = tid & 63, wave = tid >> 6;
    const int gw = blockIdx.x * NWAVES + wave, NGW = gridDim.x * NWAVES;
    const float* part = (const float*)(C.ws + WS_PART);
    f32x4 g[4];
#pragma unroll
    for (int j = 0; j < 4; ++j) g[j] = ((const f32x4*)C.in[22])[lane + 64 * j];
    for (int m = gw; m < MMAIN; m += NGW) {
        const f32x4* pp = (const f32x4*)(part + (size_t)m * 16);
        const f32x4 s4 = (pp[0] + pp[1]) + (pp[2] + pp[3]);
        const float rs = __builtin_amdgcn_rsqf(((s4.x + s4.y) + (s4.z + s4.w)) * (1.0f / D) + EPS);
        f32x4* o = (f32x4*)(C.out + (size_t)m * D);
#pragma unroll
        for (int j = 0; j < 4; ++j) o[lane + 64 * j] = o[lane + 64 * j] * rs * g[j];
    }
}

constexpr int N_PHASES = 2 + 6 * NLAYER;
struct Args { const float* in[23]; float* out; unsigned char* ws; int ph_lo, ph_hi; };
__global__ void __launch_bounds__(NTHR) hymba_fwd(Args args) {
    extern __shared__ __attribute__((aligned(16))) unsigned char lds_raw[];
    LAS unsigned char* lds = (LAS unsigned char*)lds_raw;
    cg::grid_group grid = cg::this_grid();
    Ctx C;
#pragma unroll
    for (int i = 0; i < 23; ++i) C.in[i] = args.in[i];
    C.out = args.out; C.ws = args.ws;
    unsigned char* ws = args.ws;
    const int G = gridDim.x;
    bf16* hb = (bf16*)(ws + WS_HB); float* part = (float*)(ws + WS_PART); float* hmeta = (float*)(ws + WS_HMETA);
    for (int ph = args.ph_lo; ph < args.ph_hi; ++ph) {
        if (ph > args.ph_lo) grid.sync();
#ifndef NO_P0
        if (ph == 0) { p0_prologue(C, lds); continue; }
#endif
        if (ph == N_PHASES - 1) { final_norm(C); continue; }
        const int l = (ph - 1) / 6, k = (ph - 1) % 6;
#ifndef NO_GEMM
        if (k == 0) {
            pg8::Gemm g{hb, (const bf16*)(ws + WS_WIN) + (size_t)l * D * DIN, MPAD, DIN, D}; pg8::StaticOrder S; S.init(MPAD, DIN, G, (int)blockIdx.x);
            EpiScale<false> E{(bf16*)(ws + WS_P), DIN, part};
#ifndef NO_GA
            pg8::gemm_phase<EpiScale<false>, pg8::StaticOrder, true, true>(lds, g, S, E);
#endif
        } else
#endif
        if (k == 1) {
            for (int it = blockIdx.x; it < 257; it += G) {
#ifndef NO_CP
                if (it < 256) convpool_item(C, l, it >> 7, NMETA + 64 * (it & 127), 64, lds);
                else convpool_item(C, l, 0, 0, NMETA, lds);
#endif
            }
            for (int it = blockIdx.x; it < 260; it += G) {
#ifndef NO_RG
                if (it < 256) rg_item(C, l, it >> 7, NMETA + 256 * ((it >> 2) & 31), 256, it & 3, (it >> 2) & 31, lds);
                else rg_item(C, l, 0, 0, NMETA, it - 256, -1, lds);
#endif
            }
        } else if (k == 2) {
            for (int it = blockIdx.x; it < 256; it += G) rg_fix_item(C, it >> 7, (it >> 2) & 31, it & 3);
        }
#ifndef NO_GEMM
        else if (k == 3) {
            pg8::Gemm g{(const bf16*)(ws + WS_Y), (const bf16*)(ws + WS_WOUT) + (size_t)l * D * D, MPAD, D, D}; pg8::StaticOrder S; S.init(MPAD, D, G, (int)blockIdx.x);
            EpiResid E{C.out, hmeta, hb, part};
#ifndef NO_GC
            pg8::gemm_phase<EpiResid, pg8::StaticOrder, true, true>(lds, g, S, E);
#endif
        } else if (k == 4) {
            pg8::Gemm g{hb, (const bf16*)(ws + WS_WUP) + (size_t)l * D * DFF, MPAD, DFF, D}; pg8::StaticOrder S; S.init(MPAD, DFF, G, (int)blockIdx.x);
            EpiScale<true> E{(bf16*)(ws + WS_BIG), DFF, part};
#ifndef NO_GD
            pg8::gemm_phase<EpiScale<true>, pg8::StaticOrder, true, true>(lds, g, S, E);
#endif
        } else {
            pg8::Gemm g{(const bf16*)(ws + WS_BIG), (const bf16*)(ws + WS_WDN) + (size_t)l * DFF * D, MPAD, D, DFF}; pg8::StaticOrder S; S.init(MPAD, D, G, (int)blockIdx.x);
            EpiResid E{C.out, hmeta, hb, part};
#ifndef NO_GE
            pg8::gemm_phase<EpiResid, pg8::StaticOrder, true, true>(lds, g, S, E);
#endif
        }
#endif
    }
}

extern "C" void kernel_launch(void* const* d_in, const int* in_sizes, int n_in, void* d_out, int out_size, void* d_ws, size_t ws_size, hipStream_t stream) {
    static int grid = 0;
    if (grid == 0) {
        if (n_in != 23 || out_size != MMAIN * D || ws_size < WS_END) { fprintf(stderr, "kernel_launch: unexpected shapes (n_in %d out %d ws %zu)\n", n_in, out_size, ws_size); grid = -1; return; }
        int dev = 0, cus = 0, per_cu = 0;
        hipGetDevice(&dev); hipDeviceGetAttribute(&cus, hipDeviceAttributeMultiprocessorCount, dev);
        hipFuncSetAttribute((const void*)hymba_fwd, hipFuncAttributeMaxDynamicSharedMemorySize, LDS_BYTES);
        hipOccupancyMaxActiveBlocksPerMultiprocessor(&per_cu, (const void*)hymba_fwd, NTHR, LDS_BYTES);
        if (per_cu < 1) per_cu = 1;
        (void)hipGetLastError();
        grid = cus;
    }
    if (grid < 0) return;
    Args a{};
    for (int i = 0; i < 23; ++i) a.in[i] = (const float*)d_in[i];
    a.out = (float*)d_out; a.ws = (unsigned char*)d_ws; a.ph_lo = 0; a.ph_hi = N_PHASES;
    void* kargs[] = {&a};
    hipError_t e = hipLaunchCooperativeKernel((const void*)hymba_fwd, dim3(grid), dim3(NTHR), kargs, LDS_BYTES, stream);
    if (e != hipSuccess) fprintf(stderr, "kernel_launch: cooperative launch failed: %s (grid %d)\n", hipGetErrorString(e), grid);
}
```

```cpp
#include <hip/hip_runtime.h>
#include <hip/hip_cooperative_groups.h>
#include <cstdio>
#include <cstdint>
namespace cg = cooperative_groups;
namespace pg8 {
#define PG8_LAS __attribute__((address_space(3)))
typedef unsigned short bf16_t;
typedef short bf16x8 __attribute__((ext_vector_type(8)));
typedef float f32x4 __attribute__((ext_vector_type(4)));
typedef unsigned u32x4 __attribute__((ext_vector_type(4)));
constexpr int BM = 256, BK = 64, HALF = 128, HTB = HALF * BK * 2  , STAGE_BYTES = 8 * HTB, NXCD = 8, WGM = 8;

__host__ __device__ __forceinline__ int lds_byte(int r, int c) { const int st = (r >> 4) * 2 + (c >> 5), rr = r & 15, cc = c & 31, ob = rr * 64 + cc * 2; return st * 1024 + (ob ^ (((ob >> 9) & 1) << 5)); }
__host__ __device__ __forceinline__ void stage_rc(int b, int& R, int& C) { const int st = b / 1024, sb = b % 1024, swz = sb ^ (((sb >> 9) & 1) << 5); R = (st >> 1) * 16 + swz / 64; C = (st & 1) * 32 + (swz % 64) / 2; }
__host__ __device__ __forceinline__ int perm32(int rho) { const int n = rho >> 4, i = rho & 15; return 8 * (i >> 2) + 4 * n + (i & 3); }

__device__ __forceinline__ int opaque_tid() { int t = threadIdx.x; asm volatile("" : "+v"(t)); return t; }
struct Unit { int pm, pn; };
struct Gemm { const bf16_t* A; const bf16_t* Bt; int M, N, K; };

struct StaticOrder {
    int nM, nN, nwg, G, c;
    __host__ __device__ void init(int M, int N, int G_, int c_) { nM = M / BM; nN = N / BM; nwg = nM * nN; G = G_; c = c_; }
    __host__ __device__ bool next(int i, Unit& u) const {
        const long L = (long)i * G + c; if (L >= nwg) return false;
        int wgid = (int)L; { const int q = nwg / NXCD, r = nwg % NXCD, xcd = wgid % NXCD, off = wgid / NXCD; wgid = (xcd < r ? xcd * (q + 1) : r * (q + 1) + (xcd - r) * q) + off; }
        const int nig = WGM * nN, gid = wgid / nig, fm = gid * WGM, gsz = (nM - fm) < WGM ? (nM - fm) : WGM;
        u.pm = fm + ((wgid % nig) % gsz); u.pn = (wgid % nig) / gsz; return true;
    }
    __device__ __forceinline__ void a_ready(const Unit&) const {}
    __device__ __forceinline__ void done(const Unit&) const {}
};
__device__ __forceinline__ unsigned cvt_pk_bf16(float lo, float hi) { unsigned r; asm volatile("v_cvt_pk_bf16_f32 %0, %1, %2" : "=v"(r) : "v"(lo), "v"(hi)); return r; }
template <class Epi, class Sched, bool ALIGN_EPI = false, bool SP2 = false>
__device__ __forceinline__ void gemm_phase(PG8_LAS unsigned char* lds, const Gemm g, const Sched& S, const Epi& E) {
    const int tid = opaque_tid(), wid = __builtin_amdgcn_readfirstlane(tid >> 6), lane = tid & 63, wr = wid >> 2, wc = wid & 3, fr = lane & 15, fq = lane >> 4;
    const int K = g.K, nt = K / BK;
    unsigned voffA[2], voffB[2];
#pragma unroll
    for (int i = 0; i < 2; ++i) { int R, C; stage_rc(tid * 16 + i * 8192, R, C); const int Rb = Epi::PERM ? ((R & ~31) + perm32(R & 31)) : R;
        voffA[i] = (unsigned)(R * K + C) * 2u; voffB[i] = (unsigned)(Rb * K + C) * 2u; }
    const size_t kstep = (size_t)(BK * 2);
    const size_t hstep = (size_t)HALF * K * 2;
    const size_t tstep = 2 * hstep;
    const unsigned ldsw = (unsigned)wid * 1024u;
    const int aoff = lds_byte(wr * 64 + fr, fq * 8), boff = lds_byte(wc * 32 + fr, fq * 8);
#define PG8_SA(b, h) (((b) * 2 + (h)) * HTB)
#define PG8_SB(b, h) ((4 + (b) * 2 + (h)) * HTB)
#define PG8_STAGE(bufoff, gbase, voff) do { _Pragma("unroll") for (int _i = 0; _i < 2; ++_i) \
        __builtin_amdgcn_global_load_lds((const unsigned*)((const char*)(gbase) + (voff)[_i]), (PG8_LAS unsigned*)(lds + (bufoff) + ldsw + _i * 8192), 16, 0, 0); } while (0)
#define PG8_LDA(dst, b, h) do { _Pragma("unroll") for (int m = 0; m < 4; ++m) _Pragma("unroll") for (int k = 0; k < 2; ++k) dst[m][k] = *(const PG8_LAS bf16x8*)(lds + PG8_SA(b, h) + aoff + m * 2048 + k * 1024); } while (0)
#define PG8_LDB(dst, b, h) do { _Pragma("unroll") for (int n = 0; n < 2; ++n) _Pragma("unroll") for (int k = 0; k < 2; ++k) dst[n][k] = *(const PG8_LAS bf16x8*)(lds + PG8_SB(b, h) + boff + n * 2048 + k * 1024); } while (0)
#define PG8_MMA(ai, bj, At, Bt) do { __builtin_amdgcn_s_setprio(1); _Pragma("unroll") for (int m = 0; m < 4; ++m) _Pragma("unroll") for (int n = 0; n < 2; ++n) _Pragma("unroll") for (int k = 0; k < 2; ++k) \
        acc[ai][bj][m][n] = __builtin_amdgcn_mfma_f32_16x16x32_bf16(Bt[n][k], At[m][k], acc[ai][bj][m][n], 0, 0, 0); __builtin_amdgcn_s_setprio(0); } while (0)
#define PG8_WAIT_V(n) asm volatile("s_waitcnt vmcnt(" #n ")" ::: "memory")
#define PG8_WAIT_L(n) asm volatile("s_waitcnt lgkmcnt(" #n ")" ::: "memory")
#define PG8_BAR __builtin_amdgcn_s_barrier()
#define PG8_SCHED __builtin_amdgcn_sched_barrier(0)
    Unit cur, nxt; int ui = 0;
    if (!S.next(0, cur)) return;
    f32x4 acc[2][2][4][2];
#pragma unroll
    for (int a = 0; a < 2; ++a)
#pragma unroll
        for (int b = 0; b < 2; ++b)
#pragma unroll
            for (int m = 0; m < 4; ++m)
#pragma unroll
                for (int n = 0; n < 2; ++n) acc[a][b][m][n] = (f32x4){0.f, 0.f, 0.f, 0.f};
    bf16x8 At[4][2], B0[2][2], B1[2][2];
    const char* cA = (const char*)g.A + (size_t)cur.pm * tstep; const char* cB = (const char*)g.Bt + (size_t)cur.pn * tstep;
    S.a_ready(cur);
    if constexpr (SP2) {
        PG8_STAGE(PG8_SB(0, 0), cB, voffB); PG8_STAGE(PG8_SB(0, 1), cB + hstep, voffB); PG8_STAGE(PG8_SA(0, 0), cA, voffA); PG8_STAGE(PG8_SA(0, 1), cA + hstep, voffA);
        if (wr == 1) PG8_BAR;
        PG8_WAIT_V(2); PG8_BAR;
        PG8_STAGE(PG8_SB(1, 0), cB + kstep, voffB); PG8_STAGE(PG8_SA(1, 0), cA + kstep, voffA); PG8_STAGE(PG8_SB(1, 1), cB + hstep + kstep, voffB);
        PG8_WAIT_V(6); PG8_BAR;
    } else {
        PG8_STAGE(PG8_SB(0, 0), cB, voffB); PG8_STAGE(PG8_SA(0, 0), cA, voffA); PG8_STAGE(PG8_SB(0, 1), cB + hstep, voffB); PG8_STAGE(PG8_SA(0, 1), cA + hstep, voffA);
        if (wr == 1) PG8_BAR;
        PG8_WAIT_V(4); PG8_BAR;
        PG8_STAGE(PG8_SB(1, 0), cB + kstep, voffB); PG8_STAGE(PG8_SA(1, 0), cA + kstep, voffA); PG8_STAGE(PG8_SB(1, 1), cB + hstep + kstep, voffB);
        PG8_WAIT_V(6); PG8_BAR;
    }
    for (;;) {
        const bool has_next = S.next(ui + 1, nxt);
        const char* nA = has_next ? (const char*)g.A + (size_t)nxt.pm * tstep : cA; const char* nB = has_next ? (const char*)g.Bt + (size_t)nxt.pn * tstep : cB;
        for (int t = 0; t < nt; t += 2) {
            const bool last = (t == nt - 2);
            const char* a1 = cA + (size_t)(t + 1) * kstep;
            const char* a2 = last ? nA : cA + (size_t)(t + 2) * kstep; const char* b2 = last ? nB : cB + (size_t)(t + 2) * kstep;
            const char* a3 = a2 + kstep; const char* b3 = b2 + kstep;
            if (last && has_next) S.a_ready(nxt);
            if constexpr (SP2) {
            PG8_LDB(B0, 0, 0); PG8_LDB(B1, 0, 1); PG8_SCHED; PG8_LDA(At, 0, 0); PG8_STAGE(PG8_SA(1, 1), a1 + hstep, voffA);
            PG8_WAIT_V(8); PG8_WAIT_L(0); PG8_BAR; PG8_MMA(0, 0, At, B0); PG8_MMA(0, 1, At, B1); PG8_BAR; PG8_SCHED;
            PG8_LDA(At, 0, 1); PG8_STAGE(PG8_SB(0, 0), b2, voffB); PG8_STAGE(PG8_SB(0, 1), b2 + hstep, voffB); PG8_STAGE(PG8_SA(0, 0), a2, voffA);
            PG8_WAIT_V(8); PG8_WAIT_L(0); PG8_BAR; PG8_MMA(1, 0, At, B0); PG8_MMA(1, 1, At, B1); PG8_BAR; PG8_SCHED;
            PG8_LDB(B0, 1, 0); PG8_LDB(B1, 1, 1); PG8_SCHED; PG8_LDA(At, 1, 0); PG8_STAGE(PG8_SA(0, 1), a2 + hstep, voffA);
            PG8_WAIT_V(8); PG8_WAIT_L(0); PG8_BAR; PG8_MMA(0, 0, At, B0); PG8_MMA(0, 1, At, B1); PG8_BAR; PG8_SCHED;
            PG8_LDA(At, 1, 1); PG8_STAGE(PG8_SB(1, 0), b3, voffB); PG8_STAGE(PG8_SB(1, 1), b3 + hstep, voffB); PG8_STAGE(PG8_SA(1, 0), a3, voffA);
            PG8_WAIT_V(8); PG8_WAIT_L(0); PG8_BAR; PG8_MMA(1, 0, At, B0); PG8_MMA(1, 1, At, B1); PG8_BAR; PG8_SCHED;
            } else {
            PG8_LDB(B0, 0, 0); PG8_SCHED; PG8_LDA(At, 0, 0); PG8_STAGE(PG8_SA(1, 1), a1 + hstep, voffA);
            PG8_WAIT_L(8); PG8_BAR; PG8_WAIT_L(0); PG8_MMA(0, 0, At, B0); PG8_BAR; PG8_SCHED;
            PG8_LDB(B1, 0, 1); PG8_STAGE(PG8_SB(0, 0), b2, voffB);
            PG8_BAR; PG8_WAIT_L(0); PG8_MMA(0, 1, At, B1); PG8_BAR;
            PG8_LDA(At, 0, 1); PG8_STAGE(PG8_SA(0, 0), a2, voffA);
            PG8_BAR; PG8_WAIT_L(0); PG8_MMA(1, 0, At, B0); PG8_BAR; PG8_SCHED;
            PG8_STAGE(PG8_SB(0, 1), b2 + hstep, voffB);
            PG8_WAIT_V(6); PG8_BAR; PG8_MMA(1, 1, At, B1); PG8_BAR;
            PG8_LDB(B0, 1, 0); PG8_SCHED; PG8_LDA(At, 1, 0); PG8_STAGE(PG8_SA(0, 1), a2 + hstep, voffA);
            PG8_WAIT_L(8); PG8_BAR; PG8_WAIT_L(0); PG8_MMA(0, 0, At, B0); PG8_BAR; PG8_SCHED;
            PG8_LDB(B1, 1, 1); PG8_STAGE(PG8_SB(1, 0), b3, voffB);
            PG8_BAR; PG8_WAIT_L(0); PG8_MMA(0, 1, At, B1); PG8_BAR;
            PG8_LDA(At, 1, 1); PG8_STAGE(PG8_SA(1, 0), a3, voffA);
            PG8_BAR; PG8_WAIT_L(0); PG8_MMA(1, 0, At, B0); PG8_BAR; PG8_SCHED;
            PG8_STAGE(PG8_SB(1, 1), b3 + hstep, voffB);
            PG8_WAIT_V(6); PG8_BAR; PG8_MMA(1, 1, At, B1); PG8_BAR;
            }
        }
        if constexpr (ALIGN_EPI) { if (wr == 0) PG8_BAR; }
        if constexpr (!Epi::AFTER_DRAIN) { E(acc, cur, wr, wc, fr, fq); S.done(cur); }
        if (!has_next) break;
#pragma unroll
        for (int a = 0; a < 2; ++a)
#pragma unroll
            for (int b = 0; b < 2; ++b)
#pragma unroll
                for (int m = 0; m < 4; ++m)
#pragma unroll
                    for (int n = 0; n < 2; ++n) acc[a][b][m][n] = (f32x4){0.f, 0.f, 0.f, 0.f};
        cur = nxt; cA = nA; cB = nB; ++ui;
        if constexpr (ALIGN_EPI) { if (wr == 1) PG8_BAR; }
    }
    PG8_WAIT_V(0);
    if constexpr (!ALIGN_EPI) { if (wr == 0) PG8_BAR; }
    PG8_BAR;
    if constexpr (Epi::AFTER_DRAIN) { E.fused(acc, cur, wr, wc, fr, fq, lds, wid, lane); S.done(cur); }
#undef PG8_SA
#undef PG8_SB
#undef PG8_STAGE
#undef PG8_LDA
#undef PG8_LDB
#undef PG8_MMA
#undef PG8_WAIT_V
#undef PG8_WAIT_L
#undef PG8_BAR
#undef PG8_SCHED
}
}

#define LAS __attribute__((address_space(3)))
typedef unsigned short bf16;
typedef float f32x4 __attribute__((ext_vector_type(4)));
typedef float f32x2 __attribute__((ext_vector_type(2)));
typedef short bf16x8 __attribute__((ext_vector_type(8)));
typedef unsigned u32x4 __attribute__((ext_vector_type(4)));
typedef unsigned u32x2 __attribute__((ext_vector_type(2)));

constexpr int D = 1024, SEQ = 8192, NB = 2, NMETA = 16, MMAIN = NB * SEQ, MPAD = MMAIN + 256, DIN = 1792, DFF = 4096, NLAYER = 2;
constexpr int C_POOL = 0, C_BVAL = 256, C_BGATE = 512, C_CGATE = 768, C_CX = 1280;
constexpr int DRNN = 512, DCONV = 256, DPOOL = 256, CONVK = 31;
constexpr float EPS = 1e-6f;
constexpr int NWAVES = 8, NTHR = 512;

constexpr size_t MiB = 1u << 20;
constexpr size_t WS_PART = 1 * MiB;
constexpr size_t WS_AGG = 3 * MiB;
constexpr size_t WS_HMETA = 5 * MiB;
constexpr size_t WS_SMALLW = 6 * MiB;
constexpr size_t WS_WIN = 7 * MiB, WS_WOUT = 14 * MiB, WS_WUP = 18 * MiB, WS_WDN = 34 * MiB;
constexpr size_t WS_HB = 50 * MiB;
constexpr size_t WS_BIG = 83 * MiB;
constexpr size_t WS_P = WS_BIG, WS_Y = 140 * MiB, WS_GP = 173 * MiB, WS_END = 213 * MiB;
static_assert(WS_P + (size_t)MPAD * DIN * 2 <= WS_Y && WS_Y + (size_t)MPAD * D * 2 <= WS_GP && WS_GP + (size_t)MPAD * DRNN * 2 <= WS_END && WS_BIG + (size_t)MPAD * DFF * 2 <= WS_END, "ws map");
static_assert(WS_HB + (size_t)MPAD * D * 2 <= WS_BIG, "ws map hb");
constexpr size_t SMALLW_LAYER = 512 * 1024;
constexpr size_t SW_POOL = 0, SW_PW = 32 * 1024, SW_WA = 160 * 1024, SW_WX = 224 * 1024;
constexpr size_t AG_SP = 0, AG_SH = AG_SP + NB * 128 * 512, AG_TP = AG_SH + NB * 128 * 512, AG_TH = AG_TP + NB * 32 * 512, AG_MP = AG_TH + NB * 32 * 512, AG_MH = AG_MP + 512;

constexpr int LDS_BYTES = 147456;
constexpr int ASTRIDE = 544;
constexpr int L_PA = 0, L_CA = 64 * ASTRIDE, L_STATS = 2 * 64 * ASTRIDE;
constexpr int XSTRIDE = 144, L_XS = 0, L_CST = 8 * 64 * XSTRIDE, L_AGG = L_CST + 3 * 128 * 4;
static_assert(L_STATS + 1024 <= LDS_BYTES && L_AGG + 8 * 64 * 8 <= LDS_BYTES, "lds map");

__device__ __forceinline__ float bf_lo(unsigned u) { return __uint_as_float(u << 16); }
__device__ __forceinline__ float bf_hi(unsigned u) { return __uint_as_float(u & 0xffff0000u); }
__device__ __forceinline__ unsigned pk_bf16(float lo, float hi) { return pg8::cvt_pk_bf16(lo, hi); }
__device__ __forceinline__ float sigm(float x) { return __builtin_amdgcn_rcpf(1.0f + __expf(-x)); }
__device__ __forceinline__ float gelu_tanh(float x) { return x * sigm(1.5957691216f * (x + 0.044715f * x * x * x)); }
__device__ __forceinline__ float wave_sum(float v) {
#pragma unroll
    for (int o = 1; o < 64; o <<= 1) v += __shfl_xor(v, o);
    return v;
}
template <int N> __device__ __forceinline__ float dpp_shr(float old, float x) {
    return __builtin_bit_cast(float, __builtin_amdgcn_update_dpp(__builtin_bit_cast(int, old), __builtin_bit_cast(int, x), 0x110 + N, 0xF, 0xF, false));
}
__device__ __forceinline__ int row_of(int b, int q) { return q < NMETA ? MMAIN + q : b * SEQ + q - NMETA; }

struct Ctx {
    const float* in[23]; float* out; unsigned char* ws;
};

template <bool RELU2> struct EpiScale {
    static constexpr bool PERM = true, AFTER_DRAIN = false;
    bf16* O; int ldc; const float* part;
    __device__ __forceinline__ void operator()(const pg8::f32x4 (&acc)[2][2][4][2], const pg8::Unit& u, int wr, int wc, int fr, int fq) const {
        const int row0 = u.pm * 256 + wr * 64 + fr, col0 = u.pn * 256 + wc * 32 + 8 * fq;
        const int lane = fr + 16 * fq;
        float rsl[2];
#pragma unroll
        for (int ai = 0; ai < 2; ++ai) { const f32x4* pp = (const f32x4*)(part + (size_t)(u.pm * 256 + ai * 128 + wr * 64 + lane) * 16);
            const f32x4 s4 = (pp[0] + pp[1]) + (pp[2] + pp[3]);
            rsl[ai] = __builtin_amdgcn_rsqf(((s4.x + s4.y) + (s4.z + s4.w)) * (1.0f / D) + EPS); }
        asm volatile("" ::: "memory");
#pragma unroll
        for (int ai = 0; ai < 2; ++ai)
#pragma unroll
            for (int m = 0; m < 4; ++m) {
                const int row = row0 + ai * 128 + m * 16;
                const float rs = __shfl(rsl[ai], 16 * m + fr);
                bf16* rowp = O + (size_t)row * ldc + col0;
#pragma unroll
                for (int bj = 0; bj < 2; ++bj) {
                    f32x4 v0 = acc[ai][bj][m][0] * rs, v1 = acc[ai][bj][m][1] * rs;
                    if (RELU2) {
#pragma unroll
                        for (int j = 0; j < 4; ++j) { const float a0 = fmaxf(v0[j], 0.f), a1 = fmaxf(v1[j], 0.f); v0[j] = a0 * a0; v1[j] = a1 * a1; }
                    }
                    u32x4 w; w.x = pk_bf16(v0[0], v0[1]); w.y = pk_bf16(v0[2], v0[3]); w.z = pk_bf16(v1[0], v1[1]); w.w = pk_bf16(v1[2], v1[3]);
                    *(u32x4*)(rowp + bj * 128) = w;
                }
            }
    }
};
struct EpiResid {
    static constexpr bool PERM = true, AFTER_DRAIN = false;
    bf16* hb; float* part;
    __device__ __forceinline__ void operator()(const pg8::f32x4 (&acc)[2][2][4][2], const pg8::Unit& u, int wr, int wc, int fr, int fq) const {
        const int row0 = u.pm * 256 + wr * 64 + fr, col0 = u.pn * 256 + wc * 32 + 8 * fq;
#pragma unroll
        for (int ai = 0; ai < 2; ++ai)
#pragma unroll
            for (int m = 0; m < 4; ++m) {
                const int row = row0 + ai * 128 + m * 16;
                bf16* brow = hb + (size_t)row * D + col0;
                const u32x4 h0 = *(const u32x4*)(brow), h1 = *(const u32x4*)(brow + 128);
                float ss = 0.f;
#pragma unroll
                for (int bj = 0; bj < 2; ++bj) {
                    const u32x4 hr = bj ? h1 : h0;
                    const f32x4 r0 = (f32x4){bf_lo(hr.x), bf_hi(hr.x), bf_lo(hr.y), bf_hi(hr.y)}, r1 = (f32x4){bf_lo(hr.z), bf_hi(hr.z), bf_lo(hr.w), bf_hi(hr.w)};
                    const f32x4 v0 = acc[ai][bj][m][0] + r0, v1 = acc[ai][bj][m][1] + r1;
                    u32x4 w; w.x = pk_bf16(v0[0], v0[1]); w.y = pk_bf16(v0[2], v0[3]); w.z = pk_bf16(v1[0], v1[1]); w.w = pk_bf16(v1[2], v1[3]);
                    *(u32x4*)(brow + bj * 128) = w;
                    ss += (v0[0] * v0[0] + v0[1] * v0[1]) + (v0[2] * v0[2] + v0[3] * v0[3]) + (v1[0] * v1[0] + v1[1] * v1[1]) + (v1[2] * v1[2] + v1[3] * v1[3]);
                }
                ss += __shfl_xor(ss, 16); ss += __shfl_xor(ss, 32);
                if (fq == 0) part[(size_t)row * 16 + u.pn * 4 + wc] = ss;
                if (m & 1) asm volatile("" ::: "memory");
            }
    }
};

template <int MODE  >
__device__ __forceinline__ void skinny_task(const bf16* A, const bf16* Bt, int K, int task, bf16* O, int ldo, float* part, LAS unsigned char* lds) {
    const int tid = pg8::opaque_tid(), wid = __builtin_amdgcn_readfirstlane(tid >> 6), lane = tid & 63, fr = lane & 15, fq = lane >> 4;
    const int n0 = task * 64, kw = K / 8, k0 = wid * kw;
    pg8::f32x4 acc[4];
#pragma unroll
    for (int n = 0; n < 4; ++n) acc[n] = (pg8::f32x4){0.f, 0.f, 0.f, 0.f};
    const bf16* ap = A + (size_t)fr * K + k0 + 8 * fq; const bf16* bp = Bt + (size_t)(n0 + fr) * K + k0 + 8 * fq;
#pragma unroll 4
    for (int k = 0; k < kw; k += 32) {
        const bf16x8 a = *(const bf16x8*)(ap + k);
#pragma unroll
        for (int n = 0; n < 4; ++n) { const bf16x8 bf = *(const bf16x8*)(bp + (size_t)(16 * n) * K + k); acc[n] = __builtin_amdgcn_mfma_f32_16x16x32_bf16(bf, a, acc[n], 0, 0, 0); }
    }
    LAS f32x4* red = (LAS f32x4*)lds;
#pragma unroll
    for (int n = 0; n < 4; ++n) red[(wid * 4 + n) * 64 + lane] = (f32x4){acc[n][0], acc[n][1], acc[n][2], acc[n][3]};
    __syncthreads();
    if (wid == 0) {
        f32x4 sv[4];
#pragma unroll
        for (int n = 0; n < 4; ++n) { sv[n] = red[n * 64 + lane];
#pragma unroll
            for (int w = 1; w < 8; ++w) sv[n] += red[(w * 4 + n) * 64 + lane]; }
        const int row = MMAIN + fr;
        if (MODE < 2) {
            const f32x4* pp = (const f32x4*)(part + (size_t)row * 16);
            const f32x4 s4 = (pp[0] + pp[1]) + (pp[2] + pp[3]);
            const float rs = __builtin_amdgcn_rsqf(((s4.x + s4.y) + (s4.z + s4.w)) * (1.0f / D) + EPS);
#pragma unroll
            for (int n = 0; n < 4; ++n) { f32x4 v = sv[n] * rs;
                if (MODE == 1) {
#pragma unroll
                    for (int j = 0; j < 4; ++j) { const float a0 = fmaxf(v[j], 0.f); v[j] = a0 * a0; } }
                u32x2 w; w.x = pk_bf16(v[0], v[1]); w.y = pk_bf16(v[2], v[3]);
                *(u32x2*)(O + (size_t)row * ldo + n0 + 16 * n + 4 * fq) = w; }
        } else {
            float ss = 0.f;
#pragma unroll
            for (int n = 0; n < 4; ++n) { bf16* op = O + (size_t)row * ldo + n0 + 16 * n + 4 * fq; const u32x2 hr = *(const u32x2*)op;
                const f32x4 v = sv[n] + (f32x4){bf_lo(hr.x), bf_hi(hr.x), bf_lo(hr.y), bf_hi(hr.y)};
                u32x2 w; w.x = pk_bf16(v[0], v[1]); w.y = pk_bf16(v[2], v[3]); *(u32x2*)op = w;
                ss += (v[0] * v[0] + v[1] * v[1]) + (v[2] * v[2] + v[3] * v[3]); }
            ss += __shfl_xor(ss, 16); ss += __shfl_xor(ss, 32);
            if (fq == 0) part[(size_t)row * 16 + task] = ss;
        }
    }
    __syncthreads();
}

__device__ __forceinline__ void p0_transpose_item(const float* W, int K, int N, bf16* WT, const float* gk, LAS float* scr, int item, int lane) {
    const int nblk = N / 32, kb = item / nblk, nb = item % nblk, k0 = 64 * kb, n0 = 32 * nb;
#pragma unroll 8
    for (int i = 0; i < 32; ++i) { const int kk = 2 * i + (lane >> 5); float v = W[(size_t)(k0 + kk) * N + n0 + (lane & 31)]; if (gk) v *= gk[k0 + kk]; scr[kk * 33 + (lane & 31)] = v; }
    asm volatile("s_waitcnt lgkmcnt(0)" ::: "memory");
    const int c = lane & 7;
#pragma unroll
    for (int j = 0; j < 4; ++j) { const int n = (lane >> 3) + 8 * j; const LAS float* s = scr + (8 * c) * 33 + n;
        u32x4 o; o.x = pk_bf16(s[0 * 33], s[1 * 33]); o.y = pk_bf16(s[2 * 33], s[3 * 33]); o.z = pk_bf16(s[4 * 33], s[5 * 33]); o.w = pk_bf16(s[6 * 33], s[7 * 33]);
        *(u32x4*)(WT + (size_t)(n0 + n) * K + k0 + 8 * c) = o; }
    asm volatile("s_waitcnt lgkmcnt(0)" ::: "memory");
}
__device__ __forceinline__ void p0_prologue(const Ctx& C, LAS unsigned char* lds) {
    const int tid = pg8::opaque_tid(), lane = tid & 63, wave = tid >> 6;
    LAS float* scr = (LAS float*)(lds + wave * 16384);
    const int gw = blockIdx.x * NWAVES + wave, NGW = gridDim.x * NWAVES;
    constexpr int I_IN = 16 * 56, I_OUT = 16 * 32, I_UP = 16 * 128, I_DN = 64 * 32, I_POOL = 4 * 2, I_PW = 4 * 8, I_WA = 8 * 2, I_WX = 8 * 2;
    constexpr int I_LAYER = I_IN + I_OUT + I_UP + I_DN + I_POOL + I_PW + I_WA + I_WX;
    unsigned char* ws = C.ws;
    for (int it = gw; it < NLAYER * I_LAYER; it += NGW) {
        const int l = it / I_LAYER; int r = it % I_LAYER;
        bf16* sw = (bf16*)(ws + WS_SMALLW + l * SMALLW_LAYER);
        if (r < I_IN) { p0_transpose_item(C.in[3] + (size_t)l * D * DIN, D, DIN, (bf16*)(ws + WS_WIN) + (size_t)l * D * DIN, C.in[2] + l * D, scr, r, lane); continue; } r -= I_IN;
        if (r < I_OUT) { p0_transpose_item(C.in[18] + (size_t)l * D * D, D, D, (bf16*)(ws + WS_WOUT) + (size_t)l * D * D, nullptr, scr, r, lane); continue; } r -= I_OUT;
        if (r < I_UP) { p0_transpose_item(C.in[20] + (size_t)l * D * DFF, D, DFF, (bf16*)(ws + WS_WUP) + (size_t)l * D * DFF, C.in[19] + l * D, scr, r, lane); continue; } r -= I_UP;
        if (r < I_DN) { p0_transpose_item(C.in[21] + (size_t)l * DFF * D, DFF, D, (bf16*)(ws + WS_WDN) + (size_t)l * DFF * D, nullptr, scr, r, lane); continue; } r -= I_DN;
        if (r < I_POOL) { const int g = r >> 1; p0_transpose_item(C.in[4] + (size_t)(l * 4 + g) * 4096, 64, 64, sw + SW_POOL / 2 + g * 4096, nullptr, scr, r & 1, lane); continue; } r -= I_POOL;
        if (r < I_PW) { p0_transpose_item(C.in[10] + (size_t)l * 65536, 256, 256, sw + SW_PW / 2, nullptr, scr, r, lane); continue; } r -= I_PW;
        if (r < I_WA) { const int h = r >> 1; p0_transpose_item(C.in[13] + (size_t)(l * 8 + h) * 4096, 64, 64, sw + SW_WA / 2 + h * 4096, nullptr, scr, r & 1, lane); continue; } r -= I_WA;
        { const int h = r >> 1; p0_transpose_item(C.in[15] + (size_t)(l * 8 + h) * 4096, 64, 64, sw + SW_WX / 2 + h * 4096, nullptr, scr, r & 1, lane); }
    }
    bf16* hb = (bf16*)(ws + WS_HB); float* part = (float*)(ws + WS_PART);
    for (int m = gw; m < MMAIN + NMETA; m += NGW) {
        f32x4 v[4];
        const float* src = m < MMAIN ? C.in[0] + (size_t)m * D : C.in[1] + (size_t)(m - MMAIN) * D;
        float s = 0.f;
#pragma unroll
        for (int j = 0; j < 4; ++j) { v[j] = ((const f32x4*)src)[lane + 64 * j]; s += (v[j].x * v[j].x + v[j].y * v[j].y) + (v[j].z * v[j].z + v[j].w * v[j].w); }
        s = wave_sum(s);
#pragma unroll
        for (int j = 0; j < 4; ++j) { u32x2 w; w.x = pk_bf16(v[j].x, v[j].y); w.y = pk_bf16(v[j].z, v[j].w); ((u32x2*)(hb + (size_t)m * D))[lane + 64 * j] = w; }
        if (lane < 16) part[(size_t)m * 16 + lane] = lane == 0 ? s : 0.f;
    }
}

__device__ __forceinline__ void convpool_item(const Ctx& C, int l, int b, int pos0, int nvalid, LAS unsigned char* lds) {
    const int tid = pg8::opaque_tid(), lane = tid & 63, wid = __builtin_amdgcn_readfirstlane(tid >> 6), fr = lane & 15, fq = lane >> 4;
    const int cp = (wid & 1) * 64 + lane, tg = wid >> 1;
    const bf16* P = (const bf16*)(C.ws + WS_P); bf16* Y = (bf16*)(C.ws + WS_Y);
    const bf16* sw = (const bf16*)(C.ws + WS_SMALLW + l * SMALLW_LAYER);
#ifndef NO_POOLV
    {
        const int g = wid & 3, th = wid >> 2, ch = 64 * g + lane;
        if (th * 32 < nvalid) {
        float xr[47];
#pragma unroll
        for (int i = 0; i < 47; ++i) { const int q = pos0 + th * 32 - 15 + i; const unsigned v = *(const unsigned short*)(P + (size_t)row_of(b, max(q, 0)) * DIN + C_POOL + ch); xr[i] = q >= 0 ? __uint_as_float(v << 16) : 0.f; }
#define POOL_BODY(W) do { float sum = 0.f; \
        _Pragma("unroll") for (int d = 1; d < (W); ++d) sum += xr[15 - d]; \
        _Pragma("unroll") for (int j = 0; j < 32; ++j) { const int i = j + 15; sum += xr[i]; \
            const int q = pos0 + th * 32 + j; const float inv = 1.0f / (float)min(q + 1, (W)); const float o = sum * inv - xr[i]; \
            *(LAS unsigned short*)(lds + L_PA + (th * 32 + j) * ASTRIDE + ch * 2) = (unsigned short)(pk_bf16(o, 0.f) & 0xffffu); \
            sum -= xr[i - (W) + 1]; } } while (0)
        if (g == 0) POOL_BODY(2); else if (g == 1) POOL_BODY(4); else if (g == 2) POOL_BODY(8); else POOL_BODY(16);
#undef POOL_BODY
        }
    }
#endif
#ifndef NO_CONVV
    {
        const bool act = tg * 16 < nvalid;
        f32x2 acc[16];
        if (act) {
        const float* dww = C.in[6] + (size_t)l * CONVK * DCONV + 2 * cp;
        f32x2 wk[CONVK];
#pragma unroll
        for (int k = 0; k < CONVK; ++k) wk[k] = *(const f32x2*)(dww + k * DCONV);
        const f32x2 bias = *(const f32x2*)(C.in[7] + l * DCONV + 2 * cp);
#pragma unroll
        for (int j = 0; j < 16; ++j) acc[j] = bias;
        unsigned rv[2][8], rg[2][8];
#define CONV_LOAD(c, buf) do { _Pragma("unroll") for (int ii = 0; ii < 8; ++ii) { const int i = (c) * 8 + ii; const int q = pos0 + tg * 16 - 30 + i; rv[buf][ii] = 0u; rg[buf][ii] = 0u; \
            if (i < 46) { const bf16* rp = P + (size_t)row_of(b, max(q, 0)) * DIN + 2 * cp; const unsigned t0 = *(const unsigned*)(rp + C_BVAL), t1 = *(const unsigned*)(rp + C_BGATE); rv[buf][ii] = q >= 0 ? t0 : 0u; rg[buf][ii] = t1; } } } while (0)
        CONV_LOAD(0, 0);
#pragma unroll
        for (int c = 0; c < 6; ++c) {
            asm volatile("" ::: "memory");
            if (c + 1 < 6) { if ((c & 1) == 0) CONV_LOAD(c + 1, 1); else CONV_LOAD(c + 1, 0); }
            asm volatile("" ::: "memory");
#pragma unroll
            for (int ii = 0; ii < 8; ++ii) { const int i = c * 8 + ii;
                if (i < 46) { const unsigned vv = rv[c & 1][ii], gg = rg[c & 1][ii];
                    const f32x2 u = (f32x2){bf_lo(vv) * sigm(bf_lo(gg)), bf_hi(vv) * sigm(bf_hi(gg))};
#pragma unroll
                    for (int j = 0; j < 16; ++j) { const int k = i - j; if (k >= 0 && k < CONVK) acc[j] += wk[k] * u; } } }
        }
#undef CONV_LOAD
#pragma unroll
        for (int j = 0; j < 16; ++j) {
            const float s1 = wave_sum(acc[j].x + acc[j].y), sq = wave_sum(acc[j].x * acc[j].x + acc[j].y * acc[j].y);
            if (lane == 0) *(LAS f32x2*)(lds + L_STATS + ((tg * 16 + j) * 2 + (wid & 1)) * 8) = (f32x2){s1, sq};
        }
        }
        __syncthreads();
        if (act) {
        const f32x2 lg = *(const f32x2*)(C.in[8] + l * DCONV + 2 * cp), lb = *(const f32x2*)(C.in[9] + l * DCONV + 2 * cp);
#pragma unroll
        for (int j = 0; j < 16; ++j) {
            const f32x4 st = *(LAS f32x4*)(lds + L_STATS + (tg * 16 + j) * 16);
            const float mean = (st.x + st.z) * (1.0f / DCONV), var = fmaxf((st.y + st.w) * (1.0f / DCONV) - mean * mean, 0.f), rstd = __builtin_amdgcn_rsqf(var + EPS);
            f32x2 y = (acc[j] - mean) * rstd * lg + lb;
            y.x = y.x * sigm(y.x); y.y = y.y * sigm(y.y);
            *(LAS unsigned*)(lds + L_CA + (tg * 16 + j) * ASTRIDE + cp * 4) = pk_bf16(y.x, y.y);
        }
        }
        __syncthreads();
    }
#endif
#ifndef NO_CPMM
    {
        const int n0 = 32 * wid;
        pg8::f32x4 accb[4][2], acca[4][2];
#pragma unroll
        for (int m = 0; m < 4; ++m)
#pragma unroll
            for (int n = 0; n < 2; ++n) { accb[m][n] = (pg8::f32x4){0.f, 0.f, 0.f, 0.f}; acca[m][n] = (pg8::f32x4){0.f, 0.f, 0.f, 0.f}; }
        const bf16* pwt = sw + SW_PW / 2;
#pragma unroll
        for (int kk = 0; kk < 8; ++kk) {
            bf16x8 Bf[2];
#pragma unroll
            for (int n = 0; n < 2; ++n) Bf[n] = *(const bf16x8*)(pwt + (size_t)(n0 + 16 * n + fr) * 256 + 32 * kk + 8 * fq);
#pragma unroll
            for (int m = 0; m < 4; ++m) { if (16 * m >= nvalid) continue; const bf16x8 Af = *(const LAS bf16x8*)(lds + L_CA + (16 * m + fr) * ASTRIDE + (32 * kk + 8 * fq) * 2);
#pragma unroll
                for (int n = 0; n < 2; ++n) accb[m][n] = __builtin_amdgcn_mfma_f32_16x16x32_bf16(Bf[n], Af, accb[m][n], 0, 0, 0); }
        }
        const int g = wid >> 1, d0 = n0 & 63;
        const bf16* plt = sw + SW_POOL / 2 + g * 4096;
#pragma unroll
        for (int kk = 0; kk < 2; ++kk) {
            bf16x8 Bf[2];
#pragma unroll
            for (int n = 0; n < 2; ++n) Bf[n] = *(const bf16x8*)(plt + (size_t)(d0 + 16 * n + fr) * 64 + 32 * kk + 8 * fq);
#pragma unroll
            for (int m = 0; m < 4; ++m) { if (16 * m >= nvalid) continue; const bf16x8 Af = *(const LAS bf16x8*)(lds + L_PA + (16 * m + fr) * ASTRIDE + (64 * g + 32 * kk + 8 * fq) * 2);
#pragma unroll
                for (int n = 0; n < 2; ++n) acca[m][n] = __builtin_amdgcn_mfma_f32_16x16x32_bf16(Bf[n], Af, acca[m][n], 0, 0, 0); }
        }
        const float* psc = C.in[5] + l * DPOOL;
#pragma unroll
        for (int m = 0; m < 4; ++m) { const int tok = 16 * m + fr;
            if (tok < nvalid) { bf16* yr = Y + (size_t)row_of(b, pos0 + tok) * D;
#pragma unroll
                for (int n = 0; n < 2; ++n) { const int col = n0 + 16 * n + 4 * fq; const f32x4 sc = *(const f32x4*)(psc + col);
                    const pg8::f32x4 a = acca[m][n], c = accb[m][n];
                    u32x2 wa; wa.x = pk_bf16(a[0] * sc.x, a[1] * sc.y); wa.y = pk_bf16(a[2] * sc.z, a[3] * sc.w);
                    u32x2 wb; wb.x = pk_bf16(c[0], c[1]); wb.y = pk_bf16(c[2], c[3]);
                    *(u32x2*)(yr + col) = wa; *(u32x2*)(yr + DPOOL + col) = wb; } } }
    }
#endif
    __syncthreads();
}

__device__ __forceinline__ void rg_item(const Ctx& C, int l, int b, int pos0, int nvalid, int hp, int tile, LAS unsigned char* lds) {
    const int tid = pg8::opaque_tid(), lane = tid & 63, wid = __builtin_amdgcn_readfirstlane(tid >> 6), fr = lane & 15, fq = lane >> 4;
    const int hsel = wid & 1, s = wid >> 1, hh = 2 * hp + hsel, cb = 64 * hh, q0 = pos0 + 64 * s;
    const bf16* P = (const bf16*)(C.ws + WS_P); bf16* Y = (bf16*)(C.ws + WS_Y); bf16* GPb = (bf16*)(C.ws + WS_GP);
    const bf16* sw = (const bf16*)(C.ws + WS_SMALLW + l * SMALLW_LAYER);
    float* agg = (float*)(C.ws + WS_AGG);
    LAS float* cst = (LAS float*)(lds + L_CST);
    if (tid < 128) { const int c = 128 * hp + tid; cst[tid] = C.in[14][l * DRNN + c]; cst[128 + tid] = C.in[16][l * DRNN + c]; cst[256 + tid] = 8.0f * log1pf(__expf(-C.in[17][l * DRNN + c])); }
    LAS unsigned char* xs = lds + L_XS + wid * 64 * XSTRIDE;
    const int mcnt = min(4, max(0, (nvalid - 64 * s + 15) >> 4));
    if (mcnt > 0) {
#pragma unroll
    for (int kk = 0; kk < 2; ++kk) {
        const int cx = cb + 32 * kk + 8 * fq;
        f32x4 wk[4][2];
#pragma unroll
        for (int k = 0; k < 4; ++k) { wk[k][0] = *(const f32x4*)(C.in[11] + (size_t)(l * 4 + k) * DRNN + cx); wk[k][1] = *(const f32x4*)(C.in[11] + (size_t)(l * 4 + k) * DRNN + cx + 4); }
        const f32x4 bs0 = *(const f32x4*)(C.in[12] + l * DRNN + cx), bs1 = *(const f32x4*)(C.in[12] + l * DRNN + cx + 4);
#pragma unroll 1
        for (int m = 0; m < mcnt; ++m) {
            const int q = q0 + 16 * m + fr;
            f32x4 a0 = bs0, a1 = bs1;
#pragma unroll
            for (int k = 0; k < 4; ++k) { const int qq = q - 3 + k; u32x4 raw = (u32x4){0u, 0u, 0u, 0u};
                if (qq >= 0) raw = *(const u32x4*)(P + (size_t)row_of(b, qq) * DIN + C_CX + cx);
                a0 += wk[k][0] * (f32x4){bf_lo(raw.x), bf_hi(raw.x), bf_lo(raw.y), bf_hi(raw.y)};
                a1 += wk[k][1] * (f32x4){bf_lo(raw.z), bf_hi(raw.z), bf_lo(raw.w), bf_hi(raw.w)}; }
            u32x4 pk; pk.x = pk_bf16(a0.x, a0.y); pk.y = pk_bf16(a0.z, a0.w); pk.z = pk_bf16(a1.x, a1.y); pk.w = pk_bf16(a1.z, a1.w);
            *(LAS u32x4*)(xs + (16 * m + fr) * XSTRIDE + (32 * kk + 8 * fq) * 2) = pk;
        }
    }
    }
    bf16x8 Ba[4][2], Bx[4][2];
#pragma unroll
    for (int n = 0; n < 4; ++n)
#pragma unroll
        for (int kk = 0; kk < 2; ++kk) { const size_t o = (size_t)(hh * 64 + 16 * n + fr) * 64 + 32 * kk + 8 * fq;
            Ba[n][kk] = *(const bf16x8*)(sw + SW_WA / 2 + o); Bx[n][kk] = *(const bf16x8*)(sw + SW_WX / 2 + o); }
    __syncthreads();
    f32x4 cP[4], cH[4];
#pragma unroll
    for (int n = 0; n < 4; ++n) { cP[n] = (f32x4){1.f, 1.f, 1.f, 1.f}; cH[n] = (f32x4){0.f, 0.f, 0.f, 0.f}; }
    const int bsrc = (lane & 48) | 15;
#pragma unroll 1
    for (int m = 0; m < mcnt; ++m) {
        pg8::f32x4 ga[4], gx[4];
        bf16x8 Af[2];
#pragma unroll
        for (int kk = 0; kk < 2; ++kk) Af[kk] = *(const LAS bf16x8*)(xs + (16 * m + fr) * XSTRIDE + (32 * kk + 8 * fq) * 2);
#pragma unroll
        for (int n = 0; n < 4; ++n) { ga[n] = (pg8::f32x4){0.f, 0.f, 0.f, 0.f}; gx[n] = (pg8::f32x4){0.f, 0.f, 0.f, 0.f};
#pragma unroll
            for (int kk = 0; kk < 2; ++kk) { ga[n] = __builtin_amdgcn_mfma_f32_16x16x32_bf16(Ba[n][kk], Af[kk], ga[n], 0, 0, 0); gx[n] = __builtin_amdgcn_mfma_f32_16x16x32_bf16(Bx[n][kk], Af[kk], gx[n], 0, 0, 0); } }
        const int tok = 64 * s + 16 * m + fr; const bool valid = tok < nvalid;
        const size_t row = valid ? (size_t)row_of(b, pos0 + tok) : 0;
#pragma unroll
        for (int n = 0; n < 4; ++n) {
            const int c0 = 16 * n + 4 * fq, cl = hsel * 64 + c0;
            const f32x4 ba = *(const LAS f32x4*)(cst + cl), bx = *(const LAS f32x4*)(cst + 128 + cl), sp = *(const LAS f32x4*)(cst + 256 + cl);
            const u32x2 xr = *(const LAS u32x2*)(xs + (16 * m + fr) * XSTRIDE + c0 * 2);
            const f32x4 xc = (f32x4){bf_lo(xr.x), bf_hi(xr.x), bf_lo(xr.y), bf_hi(xr.y)};
            u32x2 graw = (u32x2){0u, 0u};
            if (valid) graw = *(const u32x2*)(P + row * DIN + C_CGATE + cb + c0);
            const f32x4 gt = (f32x4){bf_lo(graw.x), bf_hi(graw.x), bf_lo(graw.y), bf_hi(graw.y)};
            f32x4 Pt, Ht;
#pragma unroll
            for (int v = 0; v < 4; ++v) {
                const float r = sigm(ga[n][v] + ba[v]), ig = sigm(gx[n][v] + bx[v]);
                const float la = -r * sp[v]; float a = __expf(la);
                const float x2 = 2.0f * la;
                const float om = x2 > -0.25f ? -x2 * (1.0f + x2 * (0.5f + x2 * (0.16666667f + x2 * (0.041666667f + x2 * (0.0083333333f + x2 * 0.0013888889f))))) : 1.0f - __expf(x2);
                float bb = __builtin_amdgcn_sqrtf(om) * ig * xc[v];
                if (!valid) { a = 1.0f; bb = 0.0f; }
                { float ap = dpp_shr<1>(1.0f, a), bp = dpp_shr<1>(0.0f, bb); bb = bb + a * bp; a = a * ap; }
                { float ap = dpp_shr<2>(1.0f, a), bp = dpp_shr<2>(0.0f, bb); bb = bb + a * bp; a = a * ap; }
                { float ap = dpp_shr<4>(1.0f, a), bp = dpp_shr<4>(0.0f, bb); bb = bb + a * bp; a = a * ap; }
                { float ap = dpp_shr<8>(1.0f, a), bp = dpp_shr<8>(0.0f, bb); bb = bb + a * bp; a = a * ap; }
                Pt[v] = a * cP[n][v]; Ht[v] = bb + a * cH[n][v];
            }
            if (valid) {
                f32x4 G;
#pragma unroll
                for (int v = 0; v < 4; ++v) G[v] = gelu_tanh(gt[v]);
                u32x2 w1; w1.x = pk_bf16(G[0] * Ht[0], G[1] * Ht[1]); w1.y = pk_bf16(G[2] * Ht[2], G[3] * Ht[3]);
                u32x2 w2; w2.x = pk_bf16(G[0] * Pt[0], G[1] * Pt[1]); w2.y = pk_bf16(G[2] * Pt[2], G[3] * Pt[3]);
                *(u32x2*)(Y + row * D + 512 + cb + c0) = w1; *(u32x2*)(GPb + row * DRNN + cb + c0) = w2;
            }
#pragma unroll
            for (int v = 0; v < 4; ++v) { cP[n][v] = __shfl(Pt[v], bsrc); cH[n][v] = __shfl(Ht[v], bsrc); }
        }
    }
    LAS float* aggL = (LAS float*)(lds + L_AGG);
    if (fr == 0) {
#pragma unroll
        for (int n = 0; n < 4; ++n)
#pragma unroll
            for (int v = 0; v < 4; ++v) { const int c0 = 16 * n + 4 * fq + v; aggL[(wid * 64 + c0) * 2] = cP[n][v]; aggL[(wid * 64 + c0) * 2 + 1] = cH[n][v]; }
        if (tile >= 0) { const size_t o = ((size_t)b * 128 + tile * 4 + s) * 512 + cb;
#pragma unroll
            for (int n = 0; n < 4; ++n) { *(f32x4*)(agg + AG_SP + o + 16 * n + 4 * fq) = cP[n]; *(f32x4*)(agg + AG_SH + o + 16 * n + 4 * fq) = cH[n]; } }
    }
    __syncthreads();
    if (wid < 2) {
        float Pt = 1.f, Ht = 0.f;
#pragma unroll
        for (int ss = 0; ss < 4; ++ss) { const f32x2 e = *(const LAS f32x2*)(aggL + (((ss * 2 + wid) * 64) + lane) * 2); Ht = e.y + e.x * Ht; Pt *= e.x; }
        if (tile >= 0) { const size_t o = ((size_t)b * 32 + tile) * 512 + cb + lane; agg[AG_TP + o] = Pt; agg[AG_TH + o] = Ht; }
        else { agg[AG_MP + cb + lane] = Pt; agg[AG_MH + cb + lane] = Ht; }
    }
    __syncthreads();
}

__device__ __forceinline__ void rg_fix_item(const Ctx& C, int b, int tile, int hp) {
    const int tid = pg8::opaque_tid(), lane = tid & 63, wid = __builtin_amdgcn_readfirstlane(tid >> 6);
    const int hsel = wid & 1, s = wid >> 1, c = 64 * (2 * hp + hsel) + 8 * (lane & 7), r8 = lane >> 3;
    bf16* Y = (bf16*)(C.ws + WS_Y); const bf16* GPb = (const bf16*)(C.ws + WS_GP); const float* agg = (const float*)(C.ws + WS_AGG);
    f32x4 H0 = *(const f32x4*)(agg + AG_MH + c), H1 = *(const f32x4*)(agg + AG_MH + c + 4);
#pragma unroll 4
    for (int jj = 0; jj < tile; ++jj) { const size_t o = ((size_t)b * 32 + jj) * 512 + c;
        const f32x4 p0 = *(const f32x4*)(agg + AG_TP + o), p1 = *(const f32x4*)(agg + AG_TP + o + 4), h0 = *(const f32x4*)(agg + AG_TH + o), h1 = *(const f32x4*)(agg + AG_TH + o + 4);
        H0 = h0 + p0 * H0; H1 = h1 + p1 * H1; }
    for (int ss = 0; ss < s; ++ss) { const size_t o = ((size_t)b * 128 + tile * 4 + ss) * 512 + c;
        const f32x4 p0 = *(const f32x4*)(agg + AG_SP + o), p1 = *(const f32x4*)(agg + AG_SP + o + 4), h0 = *(const f32x4*)(agg + AG_SH + o), h1 = *(const f32x4*)(agg + AG_SH + o + 4);
        H0 = h0 + p0 * H0; H1 = h1 + p1 * H1; }
#pragma unroll 4
    for (int it = 0; it < 8; ++it) {
        const size_t row = (size_t)b * SEQ + tile * 256 + 64 * s + 8 * it + r8;
        const u32x4 gh = *(const u32x4*)(Y + row * D + 512 + c), gp = *(const u32x4*)(GPb + row * DRNN + c);
        u32x4 o;
        o.x = pk_bf16(bf_lo(gh.x) + bf_lo(gp.x) * H0.x, bf_hi(gh.x) + bf_hi(gp.x) * H0.y);
        o.y = pk_bf16(bf_lo(gh.y) + bf_lo(gp.y) * H0.z, bf_hi(gh.y) + bf_hi(gp.y) * H0.w);
        o.z = pk_bf16(bf_lo(gh.z) + bf_lo(gp.z) * H1.x, bf_hi(gh.z) + bf_hi(gp.z) * H1.y);
        o.w = pk_bf16(bf_lo(gh.w) + bf_lo(gp.w) * H1.z, bf_hi(gh.w) + bf_hi(gp.w) * H1.w);
        *(u32x4*)(Y + row * D + 512 + c) = o;
    }
}

__device__ __forceinline__ void final_norm(const Ctx& C) {
    const int tid = pg8::opaque_tid(), lane = tid & 63, wave = tid >> 6;
    const int gw = blockIdx.x * NWAVES + wave, NGW = gridDim.x * NWAVES;
    const float* part = (const float*)(C.ws + WS_PART);
    f32x4 g[4];
#pragma unroll
    for (int j = 0; j < 4; ++j) g[j] = ((const f32x4*)C.in[22])[lane + 64 * j];
    for (int m = gw; m < MMAIN; m += NGW) {
        const f32x4* pp = (const f32x4*)(part + (size_t)m * 16);
        const f32x4 s4 = (pp[0] + pp[1]) + (pp[2] + pp[3]);
        const float rs = __builtin_amdgcn_rsqf(((s4.x + s4.y) + (s4.z + s4.w)) * (1.0f / D) + EPS);
        const u32x2* hr = (const u32x2*)((const bf16*)(C.ws + WS_HB) + (size_t)m * D);
        f32x4* o = (f32x4*)(C.out + (size_t)m * D);
#pragma unroll
        for (int j = 0; j < 4; ++j) { const u32x2 h = hr[lane + 64 * j]; o[lane + 64 * j] = (f32x4){bf_lo(h.x), bf_hi(h.x), bf_lo(h.y), bf_hi(h.y)} * rs * g[j]; }
    }
}

constexpr int N_PHASES = 2 + 6 * NLAYER;
struct Args { const float* in[23]; float* out; unsigned char* ws; int ph_lo, ph_hi; };
__global__ void __launch_bounds__(NTHR) hymba_fwd(Args args) {
    extern __shared__ __attribute__((aligned(16))) unsigned char lds_raw[];
    LAS unsigned char* lds = (LAS unsigned char*)lds_raw;
    cg::grid_group grid = cg::this_grid();
    Ctx C;
#pragma unroll
    for (int i = 0; i < 23; ++i) C.in[i] = args.in[i];
    C.out = args.out; C.ws = args.ws;
    unsigned char* ws = args.ws;
    const int G = gridDim.x;
    bf16* hb = (bf16*)(ws + WS_HB); float* part = (float*)(ws + WS_PART);
    for (int ph = args.ph_lo; ph < args.ph_hi; ++ph) {
        if (ph > args.ph_lo) grid.sync();
#ifndef NO_P0
        if (ph == 0) { p0_prologue(C, lds); continue; }
#endif
        if (ph == N_PHASES - 1) { final_norm(C); continue; }
        const int l = (ph - 1) / 6, k = (ph - 1) % 6;
#ifndef NO_GEMM
        if (k == 0) {
            const bf16* Wt = (const bf16*)(ws + WS_WIN) + (size_t)l * D * DIN;
            pg8::Gemm g{hb, Wt, MMAIN, DIN, D}; pg8::StaticOrder S; S.init(MMAIN, DIN, G, (int)blockIdx.x);
            EpiScale<false> E{(bf16*)(ws + WS_P), DIN, part};
#ifndef NO_GA
            pg8::gemm_phase<EpiScale<false>, pg8::StaticOrder, true, true>(lds, g, S, E);
#endif
            for (int t = G - 1 - (int)blockIdx.x; t < DIN / 64; t += G) skinny_task<0>(hb + (size_t)MMAIN * D, Wt, D, t, (bf16*)(ws + WS_P), DIN, part, lds);
        } else
#endif
        if (k == 1) {
            for (int it = blockIdx.x; it < 257; it += G) {
#ifndef NO_CP
                if (it < 256) convpool_item(C, l, it >> 7, NMETA + 64 * (it & 127), 64, lds);
                else convpool_item(C, l, 0, 0, NMETA, lds);
#endif
            }
            for (int it = blockIdx.x; it < 260; it += G) {
#ifndef NO_RG
                if (it < 256) rg_item(C, l, it >> 7, NMETA + 256 * ((it >> 2) & 31), 256, it & 3, (it >> 2) & 31, lds);
                else rg_item(C, l, 0, 0, NMETA, it - 256, -1, lds);
#endif
            }
        } else if (k == 2) {
            for (int it = blockIdx.x; it < 256; it += G) rg_fix_item(C, it >> 7, (it >> 2) & 31, it & 3);
        }
#ifndef NO_GEMM
        else if (k == 3) {
            const bf16* Wt = (const bf16*)(ws + WS_WOUT) + (size_t)l * D * D;
            pg8::Gemm g{(const bf16*)(ws + WS_Y), Wt, MMAIN, D, D}; pg8::StaticOrder S; S.init(MMAIN, D, G, (int)blockIdx.x);
            EpiResid E{hb, part};
#ifndef NO_GC
            pg8::gemm_phase<EpiResid, pg8::StaticOrder, true, true>(lds, g, S, E);
#endif
            for (int t = blockIdx.x; t < D / 64; t += G) skinny_task<2>((const bf16*)(ws + WS_Y) + (size_t)MMAIN * D, Wt, D, t, hb, D, part, lds);
        } else if (k == 4) {
            const bf16* Wt = (const bf16*)(ws + WS_WUP) + (size_t)l * D * DFF;
            pg8::Gemm g{hb, Wt, MMAIN, DFF, D}; pg8::StaticOrder S; S.init(MMAIN, DFF, G, (int)blockIdx.x);
            EpiScale<true> E{(bf16*)(ws + WS_BIG), DFF, part};
#ifndef NO_GD
            pg8::gemm_phase<EpiScale<true>, pg8::StaticOrder, true, true>(lds, g, S, E);
#endif
            for (int t = blockIdx.x; t < DFF / 64; t += G) skinny_task<1>(hb + (size_t)MMAIN * D, Wt, D, t, (bf16*)(ws + WS_BIG), DFF, part, lds);
        } else {
            const bf16* Wt = (const bf16*)(ws + WS_WDN) + (size_t)l * DFF * D;
            pg8::Gemm g{(const bf16*)(ws + WS_BIG), Wt, MMAIN, D, DFF}; pg8::StaticOrder S; S.init(MMAIN, D, G, (int)blockIdx.x);
            EpiResid E{hb, part};
#ifndef NO_GE
            pg8::gemm_phase<EpiResid, pg8::StaticOrder, true, true>(lds, g, S, E);
#endif
            for (int t = blockIdx.x; t < D / 64; t += G) skinny_task<2>((const bf16*)(ws + WS_BIG) + (size_t)MMAIN * DFF, Wt, DFF, t, hb, D, part, lds);
        }
#endif
    }
}

extern "C" void kernel_launch(void* const* d_in, const int* in_sizes, int n_in, void* d_out, int out_size, void* d_ws, size_t ws_size, hipStream_t stream) {
    static int grid = 0;
    if (grid == 0) {
        if (n_in != 23 || out_size != MMAIN * D || ws_size < WS_END) { fprintf(stderr, "kernel_launch: unexpected shapes (n_in %d out %d ws %zu)\n", n_in, out_size, ws_size); grid = -1; return; }
        int dev = 0, cus = 0, per_cu = 0;
        hipGetDevice(&dev); hipDeviceGetAttribute(&cus, hipDeviceAttributeMultiprocessorCount, dev);
        hipFuncSetAttribute((const void*)hymba_fwd, hipFuncAttributeMaxDynamicSharedMemorySize, LDS_BYTES);
        hipOccupancyMaxActiveBlocksPerMultiprocessor(&per_cu, (const void*)hymba_fwd, NTHR, LDS_BYTES);
        if (per_cu < 1) per_cu = 1;
        (void)hipGetLastError();
        grid = cus;
    }
    if (grid < 0) return;
    Args a{};
    for (int i = 0; i < 23; ++i) a.in[i] = (const float*)d_in[i];
    a.out = (float*)d_out; a.ws = (unsigned char*)d_ws; a.ph_lo = 0; a.ph_hi = N_PHASES;
    void* kargs[] = {&a};
    hipError_t e = hipLaunchCooperativeKernel((const void*)hymba_fwd, dim3(grid), dim3(NTHR), kargs, LDS_BYTES, stream);
    if (e != hipSuccess) fprintf(stderr, "kernel_launch: cooperative launch failed: %s (grid %d)\n", hipGetErrorString(e), grid);
}
```

```cpp
#include <hip/hip_runtime.h>
#include <hip/hip_cooperative_groups.h>
#include <cstdio>
#include <cstdint>
namespace cg = cooperative_groups;
namespace pg8 {
#define PG8_LAS __attribute__((address_space(3)))
typedef unsigned short bf16_t;
typedef short bf16x8 __attribute__((ext_vector_type(8)));
typedef float f32x4 __attribute__((ext_vector_type(4)));
typedef unsigned u32x4 __attribute__((ext_vector_type(4)));
constexpr int BM = 256, BK = 64, HALF = 128, HTB = HALF * BK * 2  , STAGE_BYTES = 8 * HTB, NXCD = 8, WGM = 8;

__host__ __device__ __forceinline__ int lds_byte(int r, int c) { const int st = (r >> 4) * 2 + (c >> 5), rr = r & 15, cc = c & 31, ob = rr * 64 + cc * 2; return st * 1024 + (ob ^ (((ob >> 9) & 1) << 5)); }
__host__ __device__ __forceinline__ void stage_rc(int b, int& R, int& C) { const int st = b / 1024, sb = b % 1024, swz = sb ^ (((sb >> 9) & 1) << 5); R = (st >> 1) * 16 + swz / 64; C = (st & 1) * 32 + (swz % 64) / 2; }
__host__ __device__ __forceinline__ int perm32(int rho) { const int n = rho >> 4, i = rho & 15; return 8 * (i >> 2) + 4 * n + (i & 3); }

__device__ __forceinline__ int opaque_tid() { int t = threadIdx.x; asm volatile("" : "+v"(t)); return t; }
struct Unit { int pm, pn; };
struct Gemm { const bf16_t* A; const bf16_t* Bt; int M, N, K; };

struct StaticOrder {
    int nM, nN, nwg, G, c;
    __host__ __device__ void init(int M, int N, int G_, int c_) { nM = M / BM; nN = N / BM; nwg = nM * nN; G = G_; c = c_; }
    __host__ __device__ bool next(int i, Unit& u) const {
        const long L = (long)i * G + c; if (L >= nwg) return false;
        int wgid = (int)L; { const int q = nwg / NXCD, r = nwg % NXCD, xcd = wgid % NXCD, off = wgid / NXCD; wgid = (xcd < r ? xcd * (q + 1) : r * (q + 1) + (xcd - r) * q) + off; }
        const int nig = WGM * nN, gid = wgid / nig, fm = gid * WGM, gsz = (nM - fm) < WGM ? (nM - fm) : WGM;
        u.pm = fm + ((wgid % nig) % gsz); u.pn = (wgid % nig) / gsz; return true;
    }
    __device__ __forceinline__ void a_ready(const Unit&) const {}
    __device__ __forceinline__ void done(const Unit&) const {}
};
__device__ __forceinline__ unsigned cvt_pk_bf16(float lo, float hi) { unsigned r; asm volatile("v_cvt_pk_bf16_f32 %0, %1, %2" : "=v"(r) : "v"(lo), "v"(hi)); return r; }
template <class Epi, class Sched, bool ALIGN_EPI = false, bool SP2 = false>
__device__ __forceinline__ void gemm_phase(PG8_LAS unsigned char* lds, const Gemm g, const Sched& S, const Epi& E) {
    const int tid = opaque_tid(), wid = __builtin_amdgcn_readfirstlane(tid >> 6), lane = tid & 63, wr = wid >> 2, wc = wid & 3, fr = lane & 15, fq = lane >> 4;
    const int K = g.K, nt = K / BK;
    unsigned voffA[2], voffB[2];
#pragma unroll
    for (int i = 0; i < 2; ++i) { int R, C; stage_rc(tid * 16 + i * 8192, R, C); const int Rb = Epi::PERM ? ((R & ~31) + perm32(R & 31)) : R;
        voffA[i] = (unsigned)(R * K + C) * 2u; voffB[i] = (unsigned)(Rb * K + C) * 2u; }
    const size_t kstep = (size_t)(BK * 2);
    const size_t hstep = (size_t)HALF * K * 2;
    const size_t tstep = 2 * hstep;
    const unsigned ldsw = (unsigned)wid * 1024u;
    const int aoff = lds_byte(wr * 64 + fr, fq * 8), boff = lds_byte(wc * 32 + fr, fq * 8);
#define PG8_SA(b, h) (((b) * 2 + (h)) * HTB)
#define PG8_SB(b, h) ((4 + (b) * 2 + (h)) * HTB)
#define PG8_STAGE(bufoff, gbase, voff) do { _Pragma("unroll") for (int _i = 0; _i < 2; ++_i) \
        __builtin_amdgcn_global_load_lds((const unsigned*)((const char*)(gbase) + (voff)[_i]), (PG8_LAS unsigned*)(lds + (bufoff) + ldsw + _i * 8192), 16, 0, 0); } while (0)
#define PG8_LDA(dst, b, h) do { _Pragma("unroll") for (int m = 0; m < 4; ++m) _Pragma("unroll") for (int k = 0; k < 2; ++k) dst[m][k] = *(const PG8_LAS bf16x8*)(lds + PG8_SA(b, h) + aoff + m * 2048 + k * 1024); } while (0)
#define PG8_LDB(dst, b, h) do { _Pragma("unroll") for (int n = 0; n < 2; ++n) _Pragma("unroll") for (int k = 0; k < 2; ++k) dst[n][k] = *(const PG8_LAS bf16x8*)(lds + PG8_SB(b, h) + boff + n * 2048 + k * 1024); } while (0)
#define PG8_MMA(ai, bj, At, Bt) do { __builtin_amdgcn_s_setprio(1); _Pragma("unroll") for (int m = 0; m < 4; ++m) _Pragma("unroll") for (int n = 0; n < 2; ++n) _Pragma("unroll") for (int k = 0; k < 2; ++k) \
        acc[ai][bj][m][n] = __builtin_amdgcn_mfma_f32_16x16x32_bf16(Bt[n][k], At[m][k], acc[ai][bj][m][n], 0, 0, 0); __builtin_amdgcn_s_setprio(0); } while (0)
#define PG8_WAIT_V(n) asm volatile("s_waitcnt vmcnt(" #n ")" ::: "memory")
#define PG8_WAIT_L(n) asm volatile("s_waitcnt lgkmcnt(" #n ")" ::: "memory")
#define PG8_BAR __builtin_amdgcn_s_barrier()
#define PG8_SCHED __builtin_amdgcn_sched_barrier(0)
    Unit cur, nxt; int ui = 0;
    if (!S.next(0, cur)) return;
    f32x4 acc[2][2][4][2];
#pragma unroll
    for (int a = 0; a < 2; ++a)
#pragma unroll
        for (int b = 0; b < 2; ++b)
#pragma unroll
            for (int m = 0; m < 4; ++m)
#pragma unroll
                for (int n = 0; n < 2; ++n) acc[a][b][m][n] = (f32x4){0.f, 0.f, 0.f, 0.f};
    bf16x8 At[4][2], B0[2][2], B1[2][2];
    const char* cA = (const char*)g.A + (size_t)cur.pm * tstep; const char* cB = (const char*)g.Bt + (size_t)cur.pn * tstep;
    S.a_ready(cur);
    if constexpr (SP2) {
        PG8_STAGE(PG8_SB(0, 0), cB, voffB); PG8_STAGE(PG8_SB(0, 1), cB + hstep, voffB); PG8_STAGE(PG8_SA(0, 0), cA, voffA); PG8_STAGE(PG8_SA(0, 1), cA + hstep, voffA);
        if (wr == 1) PG8_BAR;
        PG8_WAIT_V(2); PG8_BAR;
        PG8_STAGE(PG8_SB(1, 0), cB + kstep, voffB); PG8_STAGE(PG8_SA(1, 0), cA + kstep, voffA); PG8_STAGE(PG8_SB(1, 1), cB + hstep + kstep, voffB);
        PG8_WAIT_V(6); PG8_BAR;
    } else {
        PG8_STAGE(PG8_SB(0, 0), cB, voffB); PG8_STAGE(PG8_SA(0, 0), cA, voffA); PG8_STAGE(PG8_SB(0, 1), cB + hstep, voffB); PG8_STAGE(PG8_SA(0, 1), cA + hstep, voffA);
        if (wr == 1) PG8_BAR;
        PG8_WAIT_V(4); PG8_BAR;
        PG8_STAGE(PG8_SB(1, 0), cB + kstep, voffB); PG8_STAGE(PG8_SA(1, 0), cA + kstep, voffA); PG8_STAGE(PG8_SB(1, 1), cB + hstep + kstep, voffB);
        PG8_WAIT_V(6); PG8_BAR;
    }
    for (;;) {
        const bool has_next = S.next(ui + 1, nxt);
        const char* nA = has_next ? (const char*)g.A + (size_t)nxt.pm * tstep : cA; const char* nB = has_next ? (const char*)g.Bt + (size_t)nxt.pn * tstep : cB;
        for (int t = 0; t < nt; t += 2) {
            const bool last = (t == nt - 2);
            const char* a1 = cA + (size_t)(t + 1) * kstep;
            const char* a2 = last ? nA : cA + (size_t)(t + 2) * kstep; const char* b2 = last ? nB : cB + (size_t)(t + 2) * kstep;
            const char* a3 = a2 + kstep; const char* b3 = b2 + kstep;
            if (last && has_next) S.a_ready(nxt);
            if constexpr (SP2) {
            PG8_LDB(B0, 0, 0); PG8_LDB(B1, 0, 1); PG8_SCHED; PG8_LDA(At, 0, 0); PG8_STAGE(PG8_SA(1, 1), a1 + hstep, voffA);
            PG8_WAIT_V(8); PG8_WAIT_L(0); PG8_BAR; PG8_MMA(0, 0, At, B0); PG8_MMA(0, 1, At, B1); PG8_BAR; PG8_SCHED;
            PG8_LDA(At, 0, 1); PG8_STAGE(PG8_SB(0, 0), b2, voffB); PG8_STAGE(PG8_SB(0, 1), b2 + hstep, voffB); PG8_STAGE(PG8_SA(0, 0), a2, voffA);
            PG8_WAIT_V(8); PG8_WAIT_L(0); PG8_BAR; PG8_MMA(1, 0, At, B0); PG8_MMA(1, 1, At, B1); PG8_BAR; PG8_SCHED;
            PG8_LDB(B0, 1, 0); PG8_LDB(B1, 1, 1); PG8_SCHED; PG8_LDA(At, 1, 0); PG8_STAGE(PG8_SA(0, 1), a2 + hstep, voffA);
            PG8_WAIT_V(8); PG8_WAIT_L(0); PG8_BAR; PG8_MMA(0, 0, At, B0); PG8_MMA(0, 1, At, B1); PG8_BAR; PG8_SCHED;
            PG8_LDA(At, 1, 1); PG8_STAGE(PG8_SB(1, 0), b3, voffB); PG8_STAGE(PG8_SB(1, 1), b3 + hstep, voffB); PG8_STAGE(PG8_SA(1, 0), a3, voffA);
            PG8_WAIT_V(8); PG8_WAIT_L(0); PG8_BAR; PG8_MMA(1, 0, At, B0); PG8_MMA(1, 1, At, B1); PG8_BAR; PG8_SCHED;
            } else {
            PG8_LDB(B0, 0, 0); PG8_SCHED; PG8_LDA(At, 0, 0); PG8_STAGE(PG8_SA(1, 1), a1 + hstep, voffA);
            PG8_WAIT_L(8); PG8_BAR; PG8_WAIT_L(0); PG8_MMA(0, 0, At, B0); PG8_BAR; PG8_SCHED;
            PG8_LDB(B1, 0, 1); PG8_STAGE(PG8_SB(0, 0), b2, voffB);
            PG8_BAR; PG8_WAIT_L(0); PG8_MMA(0, 1, At, B1); PG8_BAR;
            PG8_LDA(At, 0, 1); PG8_STAGE(PG8_SA(0, 0), a2, voffA);
            PG8_BAR; PG8_WAIT_L(0); PG8_MMA(1, 0, At, B0); PG8_BAR; PG8_SCHED;
            PG8_STAGE(PG8_SB(0, 1), b2 + hstep, voffB);
            PG8_WAIT_V(6); PG8_BAR; PG8_MMA(1, 1, At, B1); PG8_BAR;
            PG8_LDB(B0, 1, 0); PG8_SCHED; PG8_LDA(At, 1, 0); PG8_STAGE(PG8_SA(0, 1), a2 + hstep, voffA);
            PG8_WAIT_L(8); PG8_BAR; PG8_WAIT_L(0); PG8_MMA(0, 0, At, B0); PG8_BAR; PG8_SCHED;
            PG8_LDB(B1, 1, 1); PG8_STAGE(PG8_SB(1, 0), b3, voffB);
            PG8_BAR; PG8_WAIT_L(0); PG8_MMA(0, 1, At, B1); PG8_BAR;
            PG8_LDA(At, 1, 1); PG8_STAGE(PG8_SA(1, 0), a3, voffA);
            PG8_BAR; PG8_WAIT_L(0); PG8_MMA(1, 0, At, B0); PG8_BAR; PG8_SCHED;
            PG8_STAGE(PG8_SB(1, 1), b3 + hstep, voffB);
            PG8_WAIT_V(6); PG8_BAR; PG8_MMA(1, 1, At, B1); PG8_BAR;
            }
        }
        if constexpr (ALIGN_EPI) { if (wr == 0) PG8_BAR; }
        if constexpr (!Epi::AFTER_DRAIN) { E(acc, cur, wr, wc, fr, fq); S.done(cur); }
        if (!has_next) break;
#pragma unroll
        for (int a = 0; a < 2; ++a)
#pragma unroll
            for (int b = 0; b < 2; ++b)
#pragma unroll
                for (int m = 0; m < 4; ++m)
#pragma unroll
                    for (int n = 0; n < 2; ++n) acc[a][b][m][n] = (f32x4){0.f, 0.f, 0.f, 0.f};
        cur = nxt; cA = nA; cB = nB; ++ui;
        if constexpr (ALIGN_EPI) { if (wr == 1) PG8_BAR; }
    }
    PG8_WAIT_V(0);
    if constexpr (!ALIGN_EPI) { if (wr == 0) PG8_BAR; }
    PG8_BAR;
    if constexpr (Epi::AFTER_DRAIN) { E.fused(acc, cur, wr, wc, fr, fq, lds, wid, lane); S.done(cur); }
#undef PG8_SA
#undef PG8_SB
#undef PG8_STAGE
#undef PG8_LDA
#undef PG8_LDB
#undef PG8_MMA
#undef PG8_WAIT_V
#undef PG8_WAIT_L
#undef PG8_BAR
#undef PG8_SCHED
}
}

#define LAS __attribute__((address_space(3)))
typedef unsigned short bf16;
typedef float f32x4 __attribute__((ext_vector_type(4)));
typedef float f32x2 __attribute__((ext_vector_type(2)));
typedef short bf16x8 __attribute__((ext_vector_type(8)));
typedef unsigned u32x4 __attribute__((ext_vector_type(4)));
typedef unsigned u32x2 __attribute__((ext_vector_type(2)));

constexpr int D = 1024, SEQ = 8192, NB = 2, NMETA = 16, MMAIN = NB * SEQ, MPAD = MMAIN + 256, DIN = 1792, DFF = 4096, NLAYER = 2;
constexpr int C_POOL = 0, C_BVAL = 256, C_BGATE = 512, C_CGATE = 768, C_CX = 1280;
constexpr int DRNN = 512, DCONV = 256, DPOOL = 256, CONVK = 31;
constexpr float EPS = 1e-6f;
constexpr int NWAVES = 8, NTHR = 512;

constexpr size_t MiB = 1u << 20;
constexpr size_t WS_CTL = 0, CTL_ZERO_BYTES = 16384;
constexpr size_t WS_PART = 1 * MiB;
constexpr size_t WS_AGG = 3 * MiB;
constexpr size_t WS_HMETA = 5 * MiB;
constexpr size_t WS_SMALLW = 6 * MiB;
constexpr size_t WS_WIN = 7 * MiB, WS_WOUT = 14 * MiB, WS_WUP = 18 * MiB, WS_WDN = 34 * MiB;
constexpr size_t WS_HB = 50 * MiB;
constexpr size_t WS_BIG = 83 * MiB;
constexpr size_t WS_P = WS_BIG, WS_Y = 140 * MiB, WS_GP = 173 * MiB, WS_END = 213 * MiB;
static_assert(WS_P + (size_t)MPAD * DIN * 2 <= WS_Y && WS_Y + (size_t)MPAD * D * 2 <= WS_GP && WS_GP + (size_t)MPAD * DRNN * 2 <= WS_END && WS_BIG + (size_t)MPAD * DFF * 2 <= WS_END, "ws map");
static_assert(WS_HB + (size_t)MPAD * D * 2 <= WS_BIG, "ws map hb");
constexpr size_t SMALLW_LAYER = 512 * 1024;
constexpr size_t SW_POOL = 0, SW_PW = 32 * 1024, SW_WA = 160 * 1024, SW_WX = 224 * 1024;
constexpr size_t AG_SP = 0, AG_SH = AG_SP + NB * 128 * 512, AG_TP = AG_SH + NB * 128 * 512, AG_TH = AG_TP + NB * 32 * 512, AG_MP = AG_TH + NB * 32 * 512, AG_MH = AG_MP + 512;

constexpr int LDS_BYTES = 147456;
constexpr int ASTRIDE = 544;
constexpr int L_PA = 0, L_CA = 64 * ASTRIDE, L_STATS = 2 * 64 * ASTRIDE;
constexpr int XSTRIDE = 144, L_XS = 0, L_CST = 8 * 64 * XSTRIDE, L_AGG = L_CST + 3 * 128 * 4;
constexpr int L_BARST = 131072 + 64;
static_assert(L_STATS + 1024 <= LDS_BYTES && L_AGG + 8 * 64 * 8 <= LDS_BYTES, "lds map");

__device__ __forceinline__ float bf_lo(unsigned u) { return __uint_as_float(u << 16); }
__device__ __forceinline__ float bf_hi(unsigned u) { return __uint_as_float(u & 0xffff0000u); }
__device__ __forceinline__ unsigned pk_bf16(float lo, float hi) { return pg8::cvt_pk_bf16(lo, hi); }
__device__ __forceinline__ float sigm(float x) { return __builtin_amdgcn_rcpf(1.0f + __expf(-x)); }
__device__ __forceinline__ float gelu_tanh(float x) { return x * sigm(1.5957691216f * (x + 0.044715f * x * x * x)); }
__device__ __forceinline__ float wave_sum(float v) {
#pragma unroll
    for (int o = 1; o < 64; o <<= 1) v += __shfl_xor(v, o);
    return v;
}
template <int N> __device__ __forceinline__ float dpp_shr(float old, float x) {
    return __builtin_bit_cast(float, __builtin_amdgcn_update_dpp(__builtin_bit_cast(int, old), __builtin_bit_cast(int, x), 0x110 + N, 0xF, 0xF, false));
}
__device__ __forceinline__ int row_of(int b, int q) { return q < NMETA ? MMAIN + q : b * SEQ + q - NMETA; }

struct Ctx {
    const float* in[23]; float* out; unsigned char* ws;
};

template <bool RELU2> struct EpiScale {
    static constexpr bool PERM = true, AFTER_DRAIN = false;
    bf16* O; int ldc; const float* part;
    __device__ __forceinline__ void operator()(const pg8::f32x4 (&acc)[2][2][4][2], const pg8::Unit& u, int wr, int wc, int fr, int fq) const {
        const int row0 = u.pm * 256 + wr * 64 + fr, col0 = u.pn * 256 + wc * 32 + 8 * fq;
        const int lane = fr + 16 * fq;
        float rsl[2];
#pragma unroll
        for (int ai = 0; ai < 2; ++ai) { const f32x4* pp = (const f32x4*)(part + (size_t)(u.pm * 256 + ai * 128 + wr * 64 + lane) * 16);
            const f32x4 s4 = (pp[0] + pp[1]) + (pp[2] + pp[3]);
            rsl[ai] = __builtin_amdgcn_rsqf(((s4.x + s4.y) + (s4.z + s4.w)) * (1.0f / D) + EPS); }
        asm volatile("" ::: "memory");
#pragma unroll
        for (int ai = 0; ai < 2; ++ai)
#pragma unroll
            for (int m = 0; m < 4; ++m) {
                const int row = row0 + ai * 128 + m * 16;
                const float rs = __shfl(rsl[ai], 16 * m + fr);
                bf16* rowp = O + (size_t)row * ldc + col0;
#pragma unroll
                for (int bj = 0; bj < 2; ++bj) {
                    f32x4 v0 = acc[ai][bj][m][0] * rs, v1 = acc[ai][bj][m][1] * rs;
                    if (RELU2) {
#pragma unroll
                        for (int j = 0; j < 4; ++j) { const float a0 = fmaxf(v0[j], 0.f), a1 = fmaxf(v1[j], 0.f); v0[j] = a0 * a0; v1[j] = a1 * a1; }
                    }
                    u32x4 w; w.x = pk_bf16(v0[0], v0[1]); w.y = pk_bf16(v0[2], v0[3]); w.z = pk_bf16(v1[0], v1[1]); w.w = pk_bf16(v1[2], v1[3]);
                    *(u32x4*)(rowp + bj * 128) = w;
                }
            }
    }
};
struct EpiResid {
    static constexpr bool PERM = true, AFTER_DRAIN = false;
    bf16* hb; float* part;
    __device__ __forceinline__ void operator()(const pg8::f32x4 (&acc)[2][2][4][2], const pg8::Unit& u, int wr, int wc, int fr, int fq) const {
        const int row0 = u.pm * 256 + wr * 64 + fr, col0 = u.pn * 256 + wc * 32 + 8 * fq;
#pragma unroll
        for (int ai = 0; ai < 2; ++ai)
#pragma unroll
            for (int m = 0; m < 4; ++m) {
                const int row = row0 + ai * 128 + m * 16;
                bf16* brow = hb + (size_t)row * D + col0;
                const u32x4 h0 = *(const u32x4*)(brow), h1 = *(const u32x4*)(brow + 128);
                float ss = 0.f;
#pragma unroll
                for (int bj = 0; bj < 2; ++bj) {
                    const u32x4 hr = bj ? h1 : h0;
                    const f32x4 r0 = (f32x4){bf_lo(hr.x), bf_hi(hr.x), bf_lo(hr.y), bf_hi(hr.y)}, r1 = (f32x4){bf_lo(hr.z), bf_hi(hr.z), bf_lo(hr.w), bf_hi(hr.w)};
                    const f32x4 v0 = acc[ai][bj][m][0] + r0, v1 = acc[ai][bj][m][1] + r1;
                    u32x4 w; w.x = pk_bf16(v0[0], v0[1]); w.y = pk_bf16(v0[2], v0[3]); w.z = pk_bf16(v1[0], v1[1]); w.w = pk_bf16(v1[2], v1[3]);
                    *(u32x4*)(brow + bj * 128) = w;
                    ss += (v0[0] * v0[0] + v0[1] * v0[1]) + (v0[2] * v0[2] + v0[3] * v0[3]) + (v1[0] * v1[0] + v1[1] * v1[1]) + (v1[2] * v1[2] + v1[3] * v1[3]);
                }
                ss += __shfl_xor(ss, 16); ss += __shfl_xor(ss, 32);
                if (fq == 0) part[(size_t)row * 16 + u.pn * 4 + wc] = ss;
                if (m & 1) asm volatile("" ::: "memory");
            }
    }
};

template <int MODE  >
__device__ __forceinline__ void skinny_task(const bf16* A, const bf16* Bt, int K, int task, bf16* O, int ldo, float* part, LAS unsigned char* lds) {
    const int tid = pg8::opaque_tid(), wid = __builtin_amdgcn_readfirstlane(tid >> 6), lane = tid & 63, fr = lane & 15, fq = lane >> 4;
    const int n0 = task * 64, kw = K / 8, k0 = wid * kw;
    pg8::f32x4 acc[4];
#pragma unroll
    for (int n = 0; n < 4; ++n) acc[n] = (pg8::f32x4){0.f, 0.f, 0.f, 0.f};
    const bf16* ap = A + (size_t)fr * K + k0 + 8 * fq; const bf16* bp = Bt + (size_t)(n0 + fr) * K + k0 + 8 * fq;
#pragma unroll 4
    for (int k = 0; k < kw; k += 32) {
        const bf16x8 a = *(const bf16x8*)(ap + k);
#pragma unroll
        for (int n = 0; n < 4; ++n) { const bf16x8 bf = *(const bf16x8*)(bp + (size_t)(16 * n) * K + k); acc[n] = __builtin_amdgcn_mfma_f32_16x16x32_bf16(bf, a, acc[n], 0, 0, 0); }
    }
    LAS f32x4* red = (LAS f32x4*)lds;
#pragma unroll
    for (int n = 0; n < 4; ++n) red[(wid * 4 + n) * 64 + lane] = (f32x4){acc[n][0], acc[n][1], acc[n][2], acc[n][3]};
    __syncthreads();
    if (wid == 0) {
        f32x4 sv[4];
#pragma unroll
        for (int n = 0; n < 4; ++n) { sv[n] = red[n * 64 + lane];
#pragma unroll
            for (int w = 1; w < 8; ++w) sv[n] += red[(w * 4 + n) * 64 + lane]; }
        const int row = MMAIN + fr;
        if (MODE < 2) {
            const f32x4* pp = (const f32x4*)(part + (size_t)row * 16);
            const f32x4 s4 = (pp[0] + pp[1]) + (pp[2] + pp[3]);
            const float rs = __builtin_amdgcn_rsqf(((s4.x + s4.y) + (s4.z + s4.w)) * (1.0f / D) + EPS);
#pragma unroll
            for (int n = 0; n < 4; ++n) { f32x4 v = sv[n] * rs;
                if (MODE == 1) {
#pragma unroll
                    for (int j = 0; j < 4; ++j) { const float a0 = fmaxf(v[j], 0.f); v[j] = a0 * a0; } }
                u32x2 w; w.x = pk_bf16(v[0], v[1]); w.y = pk_bf16(v[2], v[3]);
                *(u32x2*)(O + (size_t)row * ldo + n0 + 16 * n + 4 * fq) = w; }
        } else {
            float ss = 0.f;
#pragma unroll
            for (int n = 0; n < 4; ++n) { bf16* op = O + (size_t)row * ldo + n0 + 16 * n + 4 * fq; const u32x2 hr = *(const u32x2*)op;
                const f32x4 v = sv[n] + (f32x4){bf_lo(hr.x), bf_hi(hr.x), bf_lo(hr.y), bf_hi(hr.y)};
                u32x2 w; w.x = pk_bf16(v[0], v[1]); w.y = pk_bf16(v[2], v[3]); *(u32x2*)op = w;
                ss += (v[0] * v[0] + v[1] * v[1]) + (v[2] * v[2] + v[3] * v[3]); }
            ss += __shfl_xor(ss, 16); ss += __shfl_xor(ss, 32);
            if (fq == 0) part[(size_t)row * 16 + task] = ss;
        }
    }
    __syncthreads();
}

__device__ __forceinline__ void p0_transpose_item(const float* W, int K, int N, bf16* WT, const float* gk, LAS float* scr, int item, int lane) {
    const int nblk = N / 32, kb = item / nblk, nb = item % nblk, k0 = 64 * kb, n0 = 32 * nb;
#pragma unroll 8
    for (int i = 0; i < 32; ++i) { const int kk = 2 * i + (lane >> 5); float v = W[(size_t)(k0 + kk) * N + n0 + (lane & 31)]; if (gk) v *= gk[k0 + kk]; scr[kk * 33 + (lane & 31)] = v; }
    asm volatile("s_waitcnt lgkmcnt(0)" ::: "memory");
    const int c = lane & 7;
#pragma unroll
    for (int j = 0; j < 4; ++j) { const int n = (lane >> 3) + 8 * j; const LAS float* s = scr + (8 * c) * 33 + n;
        u32x4 o; o.x = pk_bf16(s[0 * 33], s[1 * 33]); o.y = pk_bf16(s[2 * 33], s[3 * 33]); o.z = pk_bf16(s[4 * 33], s[5 * 33]); o.w = pk_bf16(s[6 * 33], s[7 * 33]);
        *(u32x4*)(WT + (size_t)(n0 + n) * K + k0 + 8 * c) = o; }
    asm volatile("s_waitcnt lgkmcnt(0)" ::: "memory");
}
__device__ __forceinline__ void p0_prologue(const Ctx& C, LAS unsigned char* lds) {
    const int tid = pg8::opaque_tid(), lane = tid & 63, wave = tid >> 6;
    LAS float* scr = (LAS float*)(lds + wave * 16384);
    const int gw = blockIdx.x * NWAVES + wave, NGW = gridDim.x * NWAVES;
    constexpr int I_IN = 16 * 56, I_OUT = 16 * 32, I_UP = 16 * 128, I_DN = 64 * 32, I_POOL = 4 * 2, I_PW = 4 * 8, I_WA = 8 * 2, I_WX = 8 * 2;
    constexpr int I_LAYER = I_IN + I_OUT + I_UP + I_DN + I_POOL + I_PW + I_WA + I_WX;
    unsigned char* ws = C.ws;
    for (int it = gw; it < NLAYER * I_LAYER; it += NGW) {
        const int l = it / I_LAYER; int r = it % I_LAYER;
        bf16* sw = (bf16*)(ws + WS_SMALLW + l * SMALLW_LAYER);
        if (r < I_IN) { p0_transpose_item(C.in[3] + (size_t)l * D * DIN, D, DIN, (bf16*)(ws + WS_WIN) + (size_t)l * D * DIN, C.in[2] + l * D, scr, r, lane); continue; } r -= I_IN;
        if (r < I_OUT) { p0_transpose_item(C.in[18] + (size_t)l * D * D, D, D, (bf16*)(ws + WS_WOUT) + (size_t)l * D * D, nullptr, scr, r, lane); continue; } r -= I_OUT;
        if (r < I_UP) { p0_transpose_item(C.in[20] + (size_t)l * D * DFF, D, DFF, (bf16*)(ws + WS_WUP) + (size_t)l * D * DFF, C.in[19] + l * D, scr, r, lane); continue; } r -= I_UP;
        if (r < I_DN) { p0_transpose_item(C.in[21] + (size_t)l * DFF * D, DFF, D, (bf16*)(ws + WS_WDN) + (size_t)l * DFF * D, nullptr, scr, r, lane); continue; } r -= I_DN;
        if (r < I_POOL) { const int g = r >> 1; p0_transpose_item(C.in[4] + (size_t)(l * 4 + g) * 4096, 64, 64, sw + SW_POOL / 2 + g * 4096, nullptr, scr, r & 1, lane); continue; } r -= I_POOL;
        if (r < I_PW) { p0_transpose_item(C.in[10] + (size_t)l * 65536, 256, 256, sw + SW_PW / 2, nullptr, scr, r, lane); continue; } r -= I_PW;
        if (r < I_WA) { const int h = r >> 1; p0_transpose_item(C.in[13] + (size_t)(l * 8 + h) * 4096, 64, 64, sw + SW_WA / 2 + h * 4096, nullptr, scr, r & 1, lane); continue; } r -= I_WA;
        { const int h = r >> 1; p0_transpose_item(C.in[15] + (size_t)(l * 8 + h) * 4096, 64, 64, sw + SW_WX / 2 + h * 4096, nullptr, scr, r & 1, lane); }
    }
    bf16* hb = (bf16*)(ws + WS_HB); float* part = (float*)(ws + WS_PART);
    for (int m = gw; m < MMAIN + NMETA; m += NGW) {
        f32x4 v[4];
        const float* src = m < MMAIN ? C.in[0] + (size_t)m * D : C.in[1] + (size_t)(m - MMAIN) * D;
        float s = 0.f;
#pragma unroll
        for (int j = 0; j < 4; ++j) { v[j] = ((const f32x4*)src)[lane + 64 * j]; s += (v[j].x * v[j].x + v[j].y * v[j].y) + (v[j].z * v[j].z + v[j].w * v[j].w); }
        s = wave_sum(s);
#pragma unroll
        for (int j = 0; j < 4; ++j) { u32x2 w; w.x = pk_bf16(v[j].x, v[j].y); w.y = pk_bf16(v[j].z, v[j].w); ((u32x2*)(hb + (size_t)m * D))[lane + 64 * j] = w; }
        if (lane < 16) part[(size_t)m * 16 + lane] = lane == 0 ? s : 0.f;
    }
}

__device__ __forceinline__ void convpool_item(const Ctx& C, int l, int b, int pos0, int nvalid, LAS unsigned char* lds) {
    const int tid = pg8::opaque_tid(), lane = tid & 63, wid = __builtin_amdgcn_readfirstlane(tid >> 6), fr = lane & 15, fq = lane >> 4;
    const int cp = (wid & 1) * 64 + lane, tg = wid >> 1;
    const bf16* P = (const bf16*)(C.ws + WS_P); bf16* Y = (bf16*)(C.ws + WS_Y);
    const bf16* sw = (const bf16*)(C.ws + WS_SMALLW + l * SMALLW_LAYER);
#ifndef NO_POOLV
    {
        const int g = wid & 3, th = wid >> 2, ch = 64 * g + lane;
        if (th * 32 < nvalid) {
        float xr[47];
#pragma unroll
        for (int i = 0; i < 47; ++i) { const int q = pos0 + th * 32 - 15 + i; const unsigned v = *(const unsigned short*)(P + (size_t)row_of(b, max(q, 0)) * DIN + C_POOL + ch); xr[i] = q >= 0 ? __uint_as_float(v << 16) : 0.f; }
#define POOL_BODY(W) do { float sum = 0.f; \
        _Pragma("unroll") for (int d = 1; d < (W); ++d) sum += xr[15 - d]; \
        _Pragma("unroll") for (int j = 0; j < 32; ++j) { const int i = j + 15; sum += xr[i]; \
            const int q = pos0 + th * 32 + j; const float inv = 1.0f / (float)min(q + 1, (W)); const float o = sum * inv - xr[i]; \
            *(LAS unsigned short*)(lds + L_PA + (th * 32 + j) * ASTRIDE + ch * 2) = (unsigned short)(pk_bf16(o, 0.f) & 0xffffu); \
            sum -= xr[i - (W) + 1]; } } while (0)
        if (g == 0) POOL_BODY(2); else if (g == 1) POOL_BODY(4); else if (g == 2) POOL_BODY(8); else POOL_BODY(16);
#undef POOL_BODY
        }
    }
#endif
#ifndef NO_CONVV
    {
        const bool act = tg * 16 < nvalid;
        f32x2 acc[16];
        if (act) {
        const float* dww = C.in[6] + (size_t)l * CONVK * DCONV + 2 * cp;
        f32x2 wk[CONVK];
#pragma unroll
        for (int k = 0; k < CONVK; ++k) wk[k] = *(const f32x2*)(dww + k * DCONV);
        const f32x2 bias = *(const f32x2*)(C.in[7] + l * DCONV + 2 * cp);
#pragma unroll
        for (int j = 0; j < 16; ++j) acc[j] = bias;
        unsigned rv[2][8], rg[2][8];
#define CONV_LOAD(c, buf) do { _Pragma("unroll") for (int ii = 0; ii < 8; ++ii) { const int i = (c) * 8 + ii; const int q = pos0 + tg * 16 - 30 + i; rv[buf][ii] = 0u; rg[buf][ii] = 0u; \
            if (i < 46) { const bf16* rp = P + (size_t)row_of(b, max(q, 0)) * DIN + 2 * cp; const unsigned t0 = *(const unsigned*)(rp + C_BVAL), t1 = *(const unsigned*)(rp + C_BGATE); rv[buf][ii] = q >= 0 ? t0 : 0u; rg[buf][ii] = t1; } } } while (0)
        CONV_LOAD(0, 0);
#pragma unroll
        for (int c = 0; c < 6; ++c) {
            asm volatile("" ::: "memory");
            if (c + 1 < 6) { if ((c & 1) == 0) CONV_LOAD(c + 1, 1); else CONV_LOAD(c + 1, 0); }
            asm volatile("" ::: "memory");
#pragma unroll
            for (int ii = 0; ii < 8; ++ii) { const int i = c * 8 + ii;
                if (i < 46) { const unsigned vv = rv[c & 1][ii], gg = rg[c & 1][ii];
                    const f32x2 u = (f32x2){bf_lo(vv) * sigm(bf_lo(gg)), bf_hi(vv) * sigm(bf_hi(gg))};
#pragma unroll
                    for (int j = 0; j < 16; ++j) { const int k = i - j; if (k >= 0 && k < CONVK) acc[j] += wk[k] * u; } } }
        }
#undef CONV_LOAD
#pragma unroll
        for (int j = 0; j < 16; ++j) {
            const float s1 = wave_sum(acc[j].x + acc[j].y), sq = wave_sum(acc[j].x * acc[j].x + acc[j].y * acc[j].y);
            if (lane == 0) *(LAS f32x2*)(lds + L_STATS + ((tg * 16 + j) * 2 + (wid & 1)) * 8) = (f32x2){s1, sq};
        }
        }
        __syncthreads();
        if (act) {
        const f32x2 lg = *(const f32x2*)(C.in[8] + l * DCONV + 2 * cp), lb = *(const f32x2*)(C.in[9] + l * DCONV + 2 * cp);
#pragma unroll
        for (int j = 0; j < 16; ++j) {
            const f32x4 st = *(LAS f32x4*)(lds + L_STATS + (tg * 16 + j) * 16);
            const float mean = (st.x + st.z) * (1.0f / DCONV), var = fmaxf((st.y + st.w) * (1.0f / DCONV) - mean * mean, 0.f), rstd = __builtin_amdgcn_rsqf(var + EPS);
            f32x2 y = (acc[j] - mean) * rstd * lg + lb;
            y.x = y.x * sigm(y.x); y.y = y.y * sigm(y.y);
            *(LAS unsigned*)(lds + L_CA + (tg * 16 + j) * ASTRIDE + cp * 4) = pk_bf16(y.x, y.y);
        }
        }
        __syncthreads();
    }
#endif
#ifndef NO_CPMM
    {
        const int n0 = 32 * wid;
        pg8::f32x4 accb[4][2], acca[4][2];
#pragma unroll
        for (int m = 0; m < 4; ++m)
#pragma unroll
            for (int n = 0; n < 2; ++n) { accb[m][n] = (pg8::f32x4){0.f, 0.f, 0.f, 0.f}; acca[m][n] = (pg8::f32x4){0.f, 0.f, 0.f, 0.f}; }
        const bf16* pwt = sw + SW_PW / 2;
#pragma unroll
        for (int kk = 0; kk < 8; ++kk) {
            bf16x8 Bf[2];
#pragma unroll
            for (int n = 0; n < 2; ++n) Bf[n] = *(const bf16x8*)(pwt + (size_t)(n0 + 16 * n + fr) * 256 + 32 * kk + 8 * fq);
#pragma unroll
            for (int m = 0; m < 4; ++m) { if (16 * m >= nvalid) continue; const bf16x8 Af = *(const LAS bf16x8*)(lds + L_CA + (16 * m + fr) * ASTRIDE + (32 * kk + 8 * fq) * 2);
#pragma unroll
                for (int n = 0; n < 2; ++n) accb[m][n] = __builtin_amdgcn_mfma_f32_16x16x32_bf16(Bf[n], Af, accb[m][n], 0, 0, 0); }
        }
        const int g = wid >> 1, d0 = n0 & 63;
        const bf16* plt = sw + SW_POOL / 2 + g * 4096;
#pragma unroll
        for (int kk = 0; kk < 2; ++kk) {
            bf16x8 Bf[2];
#pragma unroll
            for (int n = 0; n < 2; ++n) Bf[n] = *(const bf16x8*)(plt + (size_t)(d0 + 16 * n + fr) * 64 + 32 * kk + 8 * fq);
#pragma unroll
            for (int m = 0; m < 4; ++m) { if (16 * m >= nvalid) continue; const bf16x8 Af = *(const LAS bf16x8*)(lds + L_PA + (16 * m + fr) * ASTRIDE + (64 * g + 32 * kk + 8 * fq) * 2);
#pragma unroll
                for (int n = 0; n < 2; ++n) acca[m][n] = __builtin_amdgcn_mfma_f32_16x16x32_bf16(Bf[n], Af, acca[m][n], 0, 0, 0); }
        }
        const float* psc = C.in[5] + l * DPOOL;
#pragma unroll
        for (int m = 0; m < 4; ++m) { const int tok = 16 * m + fr;
            if (tok < nvalid) { bf16* yr = Y + (size_t)row_of(b, pos0 + tok) * D;
#pragma unroll
                for (int n = 0; n < 2; ++n) { const int col = n0 + 16 * n + 4 * fq; const f32x4 sc = *(const f32x4*)(psc + col);
                    const pg8::f32x4 a = acca[m][n], c = accb[m][n];
                    u32x2 wa; wa.x = pk_bf16(a[0] * sc.x, a[1] * sc.y); wa.y = pk_bf16(a[2] * sc.z, a[3] * sc.w);
                    u32x2 wb; wb.x = pk_bf16(c[0], c[1]); wb.y = pk_bf16(c[2], c[3]);
                    *(u32x2*)(yr + col) = wa; *(u32x2*)(yr + DPOOL + col) = wb; } } }
    }
#endif
    __syncthreads();
}

__device__ __forceinline__ void rg_item(const Ctx& C, int l, int b, int pos0, int nvalid, int hp, int tile, LAS unsigned char* lds) {
    const int tid = pg8::opaque_tid(), lane = tid & 63, wid = __builtin_amdgcn_readfirstlane(tid >> 6), fr = lane & 15, fq = lane >> 4;
    const int hsel = wid & 1, s = wid >> 1, hh = 2 * hp + hsel, cb = 64 * hh, q0 = pos0 + 64 * s;
    const bf16* P = (const bf16*)(C.ws + WS_P); bf16* Y = (bf16*)(C.ws + WS_Y); bf16* GPb = (bf16*)(C.ws + WS_GP);
    const bf16* sw = (const bf16*)(C.ws + WS_SMALLW + l * SMALLW_LAYER);
    float* agg = (float*)(C.ws + WS_AGG);
    LAS float* cst = (LAS float*)(lds + L_CST);
    if (tid < 128) { const int c = 128 * hp + tid; cst[tid] = C.in[14][l * DRNN + c]; cst[128 + tid] = C.in[16][l * DRNN + c]; cst[256 + tid] = 8.0f * log1pf(__expf(-C.in[17][l * DRNN + c])); }
    LAS unsigned char* xs = lds + L_XS + wid * 64 * XSTRIDE;
    const int mcnt = min(4, max(0, (nvalid - 64 * s + 15) >> 4));
    if (mcnt > 0) {
#pragma unroll
    for (int kk = 0; kk < 2; ++kk) {
        const int cx = cb + 32 * kk + 8 * fq;
        f32x4 wk[4][2];
#pragma unroll
        for (int k = 0; k < 4; ++k) { wk[k][0] = *(const f32x4*)(C.in[11] + (size_t)(l * 4 + k) * DRNN + cx); wk[k][1] = *(const f32x4*)(C.in[11] + (size_t)(l * 4 + k) * DRNN + cx + 4); }
        const f32x4 bs0 = *(const f32x4*)(C.in[12] + l * DRNN + cx), bs1 = *(const f32x4*)(C.in[12] + l * DRNN + cx + 4);
#pragma unroll 1
        for (int m = 0; m < mcnt; ++m) {
            const int q = q0 + 16 * m + fr;
            f32x4 a0 = bs0, a1 = bs1;
#pragma unroll
            for (int k = 0; k < 4; ++k) { const int qq = q - 3 + k; u32x4 raw = (u32x4){0u, 0u, 0u, 0u};
                if (qq >= 0) raw = *(const u32x4*)(P + (size_t)row_of(b, qq) * DIN + C_CX + cx);
                a0 += wk[k][0] * (f32x4){bf_lo(raw.x), bf_hi(raw.x), bf_lo(raw.y), bf_hi(raw.y)};
                a1 += wk[k][1] * (f32x4){bf_lo(raw.z), bf_hi(raw.z), bf_lo(raw.w), bf_hi(raw.w)}; }
            u32x4 pk; pk.x = pk_bf16(a0.x, a0.y); pk.y = pk_bf16(a0.z, a0.w); pk.z = pk_bf16(a1.x, a1.y); pk.w = pk_bf16(a1.z, a1.w);
            *(LAS u32x4*)(xs + (16 * m + fr) * XSTRIDE + (32 * kk + 8 * fq) * 2) = pk;
        }
    }
    }
    bf16x8 Ba[4][2], Bx[4][2];
#pragma unroll
    for (int n = 0; n < 4; ++n)
#pragma unroll
        for (int kk = 0; kk < 2; ++kk) { const size_t o = (size_t)(hh * 64 + 16 * n + fr) * 64 + 32 * kk + 8 * fq;
            Ba[n][kk] = *(const bf16x8*)(sw + SW_WA / 2 + o); Bx[n][kk] = *(const bf16x8*)(sw + SW_WX / 2 + o); }
    __syncthreads();
    f32x4 cP[4], cH[4];
#pragma unroll
    for (int n = 0; n < 4; ++n) { cP[n] = (f32x4){1.f, 1.f, 1.f, 1.f}; cH[n] = (f32x4){0.f, 0.f, 0.f, 0.f}; }
    const int bsrc = (lane & 48) | 15;
#pragma unroll 1
    for (int m = 0; m < mcnt; ++m) {
        pg8::f32x4 ga[4], gx[4];
        bf16x8 Af[2];
#pragma unroll
        for (int kk = 0; kk < 2; ++kk) Af[kk] = *(const LAS bf16x8*)(xs + (16 * m + fr) * XSTRIDE + (32 * kk + 8 * fq) * 2);
#pragma unroll
        for (int n = 0; n < 4; ++n) { ga[n] = (pg8::f32x4){0.f, 0.f, 0.f, 0.f}; gx[n] = (pg8::f32x4){0.f, 0.f, 0.f, 0.f};
#pragma unroll
            for (int kk = 0; kk < 2; ++kk) { ga[n] = __builtin_amdgcn_mfma_f32_16x16x32_bf16(Ba[n][kk], Af[kk], ga[n], 0, 0, 0); gx[n] = __builtin_amdgcn_mfma_f32_16x16x32_bf16(Bx[n][kk], Af[kk], gx[n], 0, 0, 0); } }
        const int tok = 64 * s + 16 * m + fr; const bool valid = tok < nvalid;
        const size_t row = valid ? (size_t)row_of(b, pos0 + tok) : 0;
#pragma unroll
        for (int n = 0; n < 4; ++n) {
            const int c0 = 16 * n + 4 * fq, cl = hsel * 64 + c0;
            const f32x4 ba = *(const LAS f32x4*)(cst + cl), bx = *(const LAS f32x4*)(cst + 128 + cl), sp = *(const LAS f32x4*)(cst + 256 + cl);
            const u32x2 xr = *(const LAS u32x2*)(xs + (16 * m + fr) * XSTRIDE + c0 * 2);
            const f32x4 xc = (f32x4){bf_lo(xr.x), bf_hi(xr.x), bf_lo(xr.y), bf_hi(xr.y)};
            u32x2 graw = (u32x2){0u, 0u};
            if (valid) graw = *(const u32x2*)(P + row * DIN + C_CGATE + cb + c0);
            const f32x4 gt = (f32x4){bf_lo(graw.x), bf_hi(graw.x), bf_lo(graw.y), bf_hi(graw.y)};
            f32x4 Pt, Ht;
#pragma unroll
            for (int v = 0; v < 4; ++v) {
                const float r = sigm(ga[n][v] + ba[v]), ig = sigm(gx[n][v] + bx[v]);
                const float la = -r * sp[v]; float a = __expf(la);
                const float x2 = 2.0f * la;
                const float om = x2 > -0.25f ? -x2 * (1.0f + x2 * (0.5f + x2 * (0.16666667f + x2 * (0.041666667f + x2 * (0.0083333333f + x2 * 0.0013888889f))))) : 1.0f - __expf(x2);
                float bb = __builtin_amdgcn_sqrtf(om) * ig * xc[v];
                if (!valid) { a = 1.0f; bb = 0.0f; }
                { float ap = dpp_shr<1>(1.0f, a), bp = dpp_shr<1>(0.0f, bb); bb = bb + a * bp; a = a * ap; }
                { float ap = dpp_shr<2>(1.0f, a), bp = dpp_shr<2>(0.0f, bb); bb = bb + a * bp; a = a * ap; }
                { float ap = dpp_shr<4>(1.0f, a), bp = dpp_shr<4>(0.0f, bb); bb = bb + a * bp; a = a * ap; }
                { float ap = dpp_shr<8>(1.0f, a), bp = dpp_shr<8>(0.0f, bb); bb = bb + a * bp; a = a * ap; }
                Pt[v] = a * cP[n][v]; Ht[v] = bb + a * cH[n][v];
            }
            if (valid) {
                f32x4 G;
#pragma unroll
                for (int v = 0; v < 4; ++v) G[v] = gelu_tanh(gt[v]);
                u32x2 w1; w1.x = pk_bf16(G[0] * Ht[0], G[1] * Ht[1]); w1.y = pk_bf16(G[2] * Ht[2], G[3] * Ht[3]);
                u32x2 w2; w2.x = pk_bf16(G[0] * Pt[0], G[1] * Pt[1]); w2.y = pk_bf16(G[2] * Pt[2], G[3] * Pt[3]);
                *(u32x2*)(Y + row * D + 512 + cb + c0) = w1; *(u32x2*)(GPb + row * DRNN + cb + c0) = w2;
            }
#pragma unroll
            for (int v = 0; v < 4; ++v) { cP[n][v] = __shfl(Pt[v], bsrc); cH[n][v] = __shfl(Ht[v], bsrc); }
        }
    }
    LAS float* aggL = (LAS float*)(lds + L_AGG);
    if (fr == 0) {
#pragma unroll
        for (int n = 0; n < 4; ++n)
#pragma unroll
            for (int v = 0; v < 4; ++v) { const int c0 = 16 * n + 4 * fq + v; aggL[(wid * 64 + c0) * 2] = cP[n][v]; aggL[(wid * 64 + c0) * 2 + 1] = cH[n][v]; }
        if (tile >= 0) { const size_t o = ((size_t)b * 128 + tile * 4 + s) * 512 + cb;
#pragma unroll
            for (int n = 0; n < 4; ++n) { *(f32x4*)(agg + AG_SP + o + 16 * n + 4 * fq) = cP[n]; *(f32x4*)(agg + AG_SH + o + 16 * n + 4 * fq) = cH[n]; } }
    }
    __syncthreads();
    if (wid < 2) {
        float Pt = 1.f, Ht = 0.f;
#pragma unroll
        for (int ss = 0; ss < 4; ++ss) { const f32x2 e = *(const LAS f32x2*)(aggL + (((ss * 2 + wid) * 64) + lane) * 2); Ht = e.y + e.x * Ht; Pt *= e.x; }
        if (tile >= 0) { const size_t o = ((size_t)b * 32 + tile) * 512 + cb + lane; agg[AG_TP + o] = Pt; agg[AG_TH + o] = Ht; }
        else { agg[AG_MP + cb + lane] = Pt; agg[AG_MH + cb + lane] = Ht; }
    }
    __syncthreads();
}

__device__ __forceinline__ void rg_fix_item(const Ctx& C, int b, int tile, int hp) {
    const int tid = pg8::opaque_tid(), lane = tid & 63, wid = __builtin_amdgcn_readfirstlane(tid >> 6);
    const int hsel = wid & 1, s = wid >> 1, c = 64 * (2 * hp + hsel) + 8 * (lane & 7), r8 = lane >> 3;
    bf16* Y = (bf16*)(C.ws + WS_Y); const bf16* GPb = (const bf16*)(C.ws + WS_GP); const float* agg = (const float*)(C.ws + WS_AGG);
    f32x4 H0 = *(const f32x4*)(agg + AG_MH + c), H1 = *(const f32x4*)(agg + AG_MH + c + 4);
#pragma unroll 4
    for (int jj = 0; jj < tile; ++jj) { const size_t o = ((size_t)b * 32 + jj) * 512 + c;
        const f32x4 p0 = *(const f32x4*)(agg + AG_TP + o), p1 = *(const f32x4*)(agg + AG_TP + o + 4), h0 = *(const f32x4*)(agg + AG_TH + o), h1 = *(const f32x4*)(agg + AG_TH + o + 4);
        H0 = h0 + p0 * H0; H1 = h1 + p1 * H1; }
    for (int ss = 0; ss < s; ++ss) { const size_t o = ((size_t)b * 128 + tile * 4 + ss) * 512 + c;
        const f32x4 p0 = *(const f32x4*)(agg + AG_SP + o), p1 = *(const f32x4*)(agg + AG_SP + o + 4), h0 = *(const f32x4*)(agg + AG_SH + o), h1 = *(const f32x4*)(agg + AG_SH + o + 4);
        H0 = h0 + p0 * H0; H1 = h1 + p1 * H1; }
#pragma unroll 4
    for (int it = 0; it < 8; ++it) {
        const size_t row = (size_t)b * SEQ + tile * 256 + 64 * s + 8 * it + r8;
        const u32x4 gh = *(const u32x4*)(Y + row * D + 512 + c), gp = *(const u32x4*)(GPb + row * DRNN + c);
        u32x4 o;
        o.x = pk_bf16(bf_lo(gh.x) + bf_lo(gp.x) * H0.x, bf_hi(gh.x) + bf_hi(gp.x) * H0.y);
        o.y = pk_bf16(bf_lo(gh.y) + bf_lo(gp.y) * H0.z, bf_hi(gh.y) + bf_hi(gp.y) * H0.w);
        o.z = pk_bf16(bf_lo(gh.z) + bf_lo(gp.z) * H1.x, bf_hi(gh.z) + bf_hi(gp.z) * H1.y);
        o.w = pk_bf16(bf_lo(gh.w) + bf_lo(gp.w) * H1.z, bf_hi(gh.w) + bf_hi(gp.w) * H1.w);
        *(u32x4*)(Y + row * D + 512 + c) = o;
    }
}

__device__ __forceinline__ void final_norm(const Ctx& C) {
    const int tid = pg8::opaque_tid(), lane = tid & 63, wave = tid >> 6;
    const int gw = blockIdx.x * NWAVES + wave, NGW = gridDim.x * NWAVES;
    const float* part = (const float*)(C.ws + WS_PART);
    f32x4 g[4];
#pragma unroll
    for (int j = 0; j < 4; ++j) g[j] = ((const f32x4*)C.in[22])[lane + 64 * j];
    for (int m = gw; m < MMAIN; m += NGW) {
        const f32x4* pp = (const f32x4*)(part + (size_t)m * 16);
        const f32x4 s4 = (pp[0] + pp[1]) + (pp[2] + pp[3]);
        const float rs = __builtin_amdgcn_rsqf(((s4.x + s4.y) + (s4.z + s4.w)) * (1.0f / D) + EPS);
        const u32x2* hr = (const u32x2*)((const bf16*)(C.ws + WS_HB) + (size_t)m * D);
        f32x4* o = (f32x4*)(C.out + (size_t)m * D);
#pragma unroll
        for (int j = 0; j < 4; ++j) { const u32x2 h = hr[lane + 64 * j]; o[lane + 64 * j] = (f32x4){bf_lo(h.x), bf_hi(h.x), bf_lo(h.y), bf_hi(h.y)} * rs * g[j]; }
    }
}

#define XB_TMO      128
#define XB_XCNT(j)  (256  + 64 * (j))
#define XB_XSUB(j)  (1280 + 64 * (j))
#define XB_XGEN(j)  (2304 + 64 * (j))
#define XB_TOP      3328
#define XB_TOPGEN   3392
#define XCD_BAR_WORDS 3456
#define XB_SPIN_CAP (1u << 18)

__device__ __forceinline__ unsigned xb_ld(unsigned* p)              { return __hip_atomic_load(p, __ATOMIC_RELAXED, __HIP_MEMORY_SCOPE_AGENT); }
__device__ __forceinline__ unsigned xb_add(unsigned* p, unsigned v) { return __hip_atomic_fetch_add(p, v, __ATOMIC_RELAXED, __HIP_MEMORY_SCOPE_AGENT); }
__device__ __forceinline__ unsigned xb_xcc_id() { return (unsigned)__builtin_amdgcn_s_getreg((3 << 11) | 20) & 0xFu; }
#define XB_SPIN(cond, bar) do { unsigned _sp = 0; while (cond) { __builtin_amdgcn_s_sleep(1); \
    if ((++_sp & 255u) == 0u) { if (xb_ld(&(bar)[XB_TMO])) break; if (_sp > XB_SPIN_CAP) { atomicAdd(&(bar)[XB_TMO], 1u); break; } } } } while (0)

struct XcdBarrier {
    unsigned* bar; unsigned x;
    volatile LAS unsigned* st;
};

__device__ __forceinline__ XcdBarrier xcd_barrier_post(unsigned* bar, volatile LAS unsigned* st) {
    XcdBarrier b; b.bar = bar; b.x = xb_xcc_id(); b.st = st;
    if (threadIdx.x == 0) (void)xb_add(&bar[XB_XCNT(b.x)], 1u);
    return b;
}
__device__ __forceinline__ void xcd_barrier_complete(unsigned* bar, unsigned x, unsigned& nloc, unsigned& nx) {
    const unsigned G = gridDim.x * gridDim.y * gridDim.z;
    unsigned sum, cnt, mine, sp = 0u;
    for (;;) {
        sum = 0u; cnt = 0u; mine = 0u;
#pragma unroll
        for (unsigned j = 0; j < 16; ++j) { const unsigned c = xb_ld(&bar[XB_XCNT(j)]); sum += c; cnt += (c > 0u) ? 1u : 0u; mine = (j == x) ? c : mine; }
        if (sum == G) break;
        __builtin_amdgcn_s_sleep(1);
        if ((++sp & 255u) == 0u) { if (xb_ld(&bar[XB_TMO])) break; if (sp > XB_SPIN_CAP) { atomicAdd(&bar[XB_TMO], 1u); break; } }
    }
    nloc = mine > 0u ? mine : 1u; nx = cnt > 0u ? cnt : 1u;
}

__device__ __forceinline__ void xcd_barrier(const XcdBarrier& b) {
    asm volatile("s_waitcnt vmcnt(0)" ::: "memory");
    __syncthreads();
    if (threadIdx.x == 0) {
        unsigned* bar = b.bar;
        __builtin_amdgcn_s_waitcnt(0);
        unsigned nloc = b.st[0], nx = b.st[1];
        if (nloc == 0u) { xcd_barrier_complete(bar, b.x, nloc, nx); b.st[0] = nloc; b.st[1] = nx; }
        const unsigned old = xb_add(&bar[XB_XSUB(b.x)], 1u);
        const unsigned gen = old / nloc;
        if (old + 1u == (gen + 1u) * nloc) {
            __builtin_amdgcn_fence(__ATOMIC_RELEASE, "agent");
            asm volatile("s_waitcnt vmcnt(0)" ::: "memory");
            const unsigned og = xb_add(&bar[XB_TOP], 1u);
            const unsigned tg = og / nx;
            if (og + 1u == (tg + 1u) * nx) xb_add(&bar[XB_TOPGEN], 1u);
            else XB_SPIN(xb_ld(&bar[XB_TOPGEN]) == tg, bar);
            __builtin_amdgcn_fence(__ATOMIC_ACQUIRE, "agent");
            xb_add(&bar[XB_XGEN(b.x)], 1u);
            asm volatile("s_waitcnt vmcnt(0)" ::: "memory");
        } else {
            XB_SPIN(xb_ld(&bar[XB_XGEN(b.x)]) == gen, bar);
            __builtin_amdgcn_fence(__ATOMIC_ACQUIRE, "agent");
            asm volatile("s_waitcnt vmcnt(0)" ::: "memory");
        }
    }
    __syncthreads();
}

constexpr int N_PHASES = 2 + 6 * NLAYER;
struct Args { const float* in[23]; float* out; unsigned char* ws; int ph_lo, ph_hi; };
__global__ void __launch_bounds__(NTHR) hymba_fwd(Args args) {
    extern __shared__ __attribute__((aligned(16))) unsigned char lds_raw[];
    LAS unsigned char* lds = (LAS unsigned char*)lds_raw;
    cg::grid_group grid = cg::this_grid();
    if (args.ph_hi < 0) grid.sync();
    { volatile LAS unsigned* st0 = (volatile LAS unsigned*)(lds + L_BARST); if (threadIdx.x < 16) st0[threadIdx.x] = 0u; }
    __syncthreads();
    XcdBarrier xbar = xcd_barrier_post((unsigned*)(args.ws + WS_CTL), (volatile LAS unsigned*)(lds + L_BARST));
    Ctx C;
#pragma unroll
    for (int i = 0; i < 23; ++i) C.in[i] = args.in[i];
    C.out = args.out; C.ws = args.ws;
    unsigned char* ws = args.ws;
    const int G = gridDim.x;
    bf16* hb = (bf16*)(ws + WS_HB); float* part = (float*)(ws + WS_PART);
#ifndef PROBE_REP
#define PROBE_REP 0
#endif
#ifndef PROBE_SYNCS
#define PROBE_SYNCS 0
#endif
    for (int ph = args.ph_lo; ph < args.ph_hi; ++ph) {
        if (ph > args.ph_lo) xcd_barrier(xbar);
        if (PROBE_SYNCS && ph == 1) for (int e = 0; e < PROBE_SYNCS; ++e) xcd_barrier(xbar);
        const int pkind = ph == 0 ? 0 : (ph == N_PHASES - 1 ? 7 : 1 + (ph - 1) % 6);
        const int nrep = 1 + ((PROBE_REP >> pkind) & 1);
        for (int rep = 0; rep < nrep; ++rep) {
#ifndef NO_P0
        if (ph == 0) { p0_prologue(C, lds); continue; }
#endif
        if (ph == N_PHASES - 1) { final_norm(C); continue; }
        const int l = (ph - 1) / 6, k = (ph - 1) % 6;
#ifndef NO_GEMM
        if (k == 0) {
            const bf16* Wt = (const bf16*)(ws + WS_WIN) + (size_t)l * D * DIN;
            pg8::Gemm g{hb, Wt, MMAIN, DIN, D}; pg8::StaticOrder S; S.init(MMAIN, DIN, G, (int)blockIdx.x);
            EpiScale<false> E{(bf16*)(ws + WS_P), DIN, part};
#ifndef NO_GA
            pg8::gemm_phase<EpiScale<false>, pg8::StaticOrder, true, true>(lds, g, S, E);
#endif
            for (int t = G - 1 - (int)blockIdx.x; t < DIN / 64; t += G) skinny_task<0>(hb + (size_t)MMAIN * D, Wt, D, t, (bf16*)(ws + WS_P), DIN, part, lds);
        } else
#endif
        if (k == 1) {
            for (int r2 = 0; r2 <= ((PROBE_REP >> 8) & 1); ++r2)
            for (int it = blockIdx.x; it < 257; it += G) {
#ifndef NO_CP
                if (it < 256) convpool_item(C, l, it >> 7, NMETA + 64 * (it & 127), 64, lds);
                else convpool_item(C, l, 0, 0, NMETA, lds);
#endif
            }
            for (int r2 = 0; r2 <= ((PROBE_REP >> 9) & 1); ++r2)
            for (int it = blockIdx.x; it < 260; it += G) {
#ifndef NO_RG
                if (it < 256) rg_item(C, l, it >> 7, NMETA + 256 * ((it >> 2) & 31), 256, it & 3, (it >> 2) & 31, lds);
                else rg_item(C, l, 0, 0, NMETA, it - 256, -1, lds);
#endif
            }
        } else if (k == 2) {
            for (int it = blockIdx.x; it < 256; it += G) rg_fix_item(C, it >> 7, (it >> 2) & 31, it & 3);
        }
#ifndef NO_GEMM
        else if (k == 3) {
            const bf16* Wt = (const bf16*)(ws + WS_WOUT) + (size_t)l * D * D;
            pg8::Gemm g{(const bf16*)(ws + WS_Y), Wt, MMAIN, D, D}; pg8::StaticOrder S; S.init(MMAIN, D, G, (int)blockIdx.x);
            EpiResid E{hb, part};
#ifndef NO_GC
            pg8::gemm_phase<EpiResid, pg8::StaticOrder, true, true>(lds, g, S, E);
#endif
            for (int t = blockIdx.x; t < D / 64; t += G) skinny_task<2>((const bf16*)(ws + WS_Y) + (size_t)MMAIN * D, Wt, D, t, hb, D, part, lds);
        } else if (k == 4) {
            const bf16* Wt = (const bf16*)(ws + WS_WUP) + (size_t)l * D * DFF;
            pg8::Gemm g{hb, Wt, MMAIN, DFF, D}; pg8::StaticOrder S; S.init(MMAIN, DFF, G, (int)blockIdx.x);
            EpiScale<true> E{(bf16*)(ws + WS_BIG), DFF, part};
#ifndef NO_GD
            pg8::gemm_phase<EpiScale<true>, pg8::StaticOrder, true, true>(lds, g, S, E);
#endif
            for (int t = blockIdx.x; t < DFF / 64; t += G) skinny_task<1>(hb + (size_t)MMAIN * D, Wt, D, t, (bf16*)(ws + WS_BIG), DFF, part, lds);
        } else {
            const bf16* Wt = (const bf16*)(ws + WS_WDN) + (size_t)l * DFF * D;
            pg8::Gemm g{(const bf16*)(ws + WS_BIG), Wt, MMAIN, D, DFF}; pg8::StaticOrder S; S.init(MMAIN, D, G, (int)blockIdx.x);
            EpiResid E{hb, part};
#ifndef NO_GE
            pg8::gemm_phase<EpiResid, pg8::StaticOrder, true, true>(lds, g, S, E);
#endif
            for (int t = blockIdx.x; t < D / 64; t += G) skinny_task<2>((const bf16*)(ws + WS_BIG) + (size_t)MMAIN * DFF, Wt, DFF, t, hb, D, part, lds);
        }
#endif
        }
    }
}

extern "C" void kernel_launch(void* const* d_in, const int* in_sizes, int n_in, void* d_out, int out_size, void* d_ws, size_t ws_size, hipStream_t stream) {
    static int grid = 0;
    if (grid == 0) {
        if (n_in != 23 || out_size != MMAIN * D || ws_size < WS_END) { fprintf(stderr, "kernel_launch: unexpected shapes (n_in %d out %d ws %zu)\n", n_in, out_size, ws_size); grid = -1; return; }
        int dev = 0, cus = 0, per_cu = 0;
        hipGetDevice(&dev); hipDeviceGetAttribute(&cus, hipDeviceAttributeMultiprocessorCount, dev);
        hipFuncSetAttribute((const void*)hymba_fwd, hipFuncAttributeMaxDynamicSharedMemorySize, LDS_BYTES);
        hipOccupancyMaxActiveBlocksPerMultiprocessor(&per_cu, (const void*)hymba_fwd, NTHR, LDS_BYTES);
        if (per_cu < 1) per_cu = 1;
        (void)hipGetLastError();
        grid = cus;
    }
    if (grid < 0) return;
    if (hipMemsetAsync((char*)d_ws + WS_CTL, 0, CTL_ZERO_BYTES, stream) != hipSuccess) { fprintf(stderr, "kernel_launch: memset failed\n"); return; }
    Args a{};
    for (int i = 0; i < 23; ++i) a.in[i] = (const float*)d_in[i];
    a.out = (float*)d_out; a.ws = (unsigned char*)d_ws; a.ph_lo = 0; a.ph_hi = N_PHASES;
    void* kargs[] = {&a};
    hipError_t e = hipLaunchCooperativeKernel((const void*)hymba_fwd, dim3(grid), dim3(NTHR), kargs, LDS_BYTES, stream);
    if (e != hipSuccess) fprintf(stderr, "kernel_launch: cooperative launch failed: %s (grid %d)\n", hipGetErrorString(e), grid);
}
```

```cpp
#include <hip/hip_runtime.h>
#include <hip/hip_cooperative_groups.h>
#include <cstdio>
#include <cstdint>
namespace cg = cooperative_groups;
namespace pg8 {
#define PG8_LAS __attribute__((address_space(3)))
typedef unsigned short bf16_t;
typedef short bf16x8 __attribute__((ext_vector_type(8)));
typedef float f32x4 __attribute__((ext_vector_type(4)));
typedef unsigned u32x4 __attribute__((ext_vector_type(4)));
constexpr int BM = 256, BK = 64, HALF = 128, HTB = HALF * BK * 2  , STAGE_BYTES = 8 * HTB, NXCD = 8, WGM = 8;

__host__ __device__ __forceinline__ int lds_byte(int r, int c) { const int st = (r >> 4) * 2 + (c >> 5), rr = r & 15, cc = c & 31, ob = rr * 64 + cc * 2; return st * 1024 + (ob ^ (((ob >> 9) & 1) << 5)); }
__host__ __device__ __forceinline__ void stage_rc(int b, int& R, int& C) { const int st = b / 1024, sb = b % 1024, swz = sb ^ (((sb >> 9) & 1) << 5); R = (st >> 1) * 16 + swz / 64; C = (st & 1) * 32 + (swz % 64) / 2; }
__host__ __device__ __forceinline__ int perm32(int rho) { const int n = rho >> 4, i = rho & 15; return 8 * (i >> 2) + 4 * n + (i & 3); }

__device__ __forceinline__ int opaque_tid() { int t = threadIdx.x; asm volatile("" : "+v"(t)); return t; }
struct Unit { int pm, pn; };
struct Gemm { const bf16_t* A; const bf16_t* Bt; int M, N, K; };

struct StaticOrder {
    int nM, nN, nwg, G, c;
    __host__ __device__ void init(int M, int N, int G_, int c_) { nM = M / BM; nN = N / BM; nwg = nM * nN; G = G_; c = c_; }
    __host__ __device__ bool next(int i, Unit& u) const {
        const long L = (long)i * G + c; if (L >= nwg) return false;
        int wgid = (int)L; { const int q = nwg / NXCD, r = nwg % NXCD, xcd = wgid % NXCD, off = wgid / NXCD; wgid = (xcd < r ? xcd * (q + 1) : r * (q + 1) + (xcd - r) * q) + off; }
        const int nig = WGM * nN, gid = wgid / nig, fm = gid * WGM, gsz = (nM - fm) < WGM ? (nM - fm) : WGM;
        u.pm = fm + ((wgid % nig) % gsz); u.pn = (wgid % nig) / gsz; return true;
    }
    __device__ __forceinline__ void a_ready(const Unit&) const {}
    __device__ __forceinline__ void done(const Unit&) const {}
};
__device__ __forceinline__ unsigned cvt_pk_bf16(float lo, float hi) { unsigned r; asm volatile("v_cvt_pk_bf16_f32 %0, %1, %2" : "=v"(r) : "v"(lo), "v"(hi)); return r; }
template <class Epi, class Sched, bool ALIGN_EPI = false, bool SP2 = false>
__device__ __forceinline__ void gemm_phase(PG8_LAS unsigned char* lds, const Gemm g, const Sched& S, const Epi& E) {
    const int tid = opaque_tid(), wid = __builtin_amdgcn_readfirstlane(tid >> 6), lane = tid & 63, wr = wid >> 2, wc = wid & 3, fr = lane & 15, fq = lane >> 4;
    const int K = g.K, nt = K / BK;
    unsigned voffA[2], voffB[2];
#pragma unroll
    for (int i = 0; i < 2; ++i) { int R, C; stage_rc(tid * 16 + i * 8192, R, C); const int Rb = Epi::PERM ? ((R & ~31) + perm32(R & 31)) : R;
        voffA[i] = (unsigned)(R * K + C) * 2u; voffB[i] = (unsigned)(Rb * K + C) * 2u; }
    const size_t kstep = (size_t)(BK * 2);
    const size_t hstep = (size_t)HALF * K * 2;
    const size_t tstep = 2 * hstep;
    const unsigned ldsw = (unsigned)wid * 1024u;
    const int aoff = lds_byte(wr * 64 + fr, fq * 8), boff = lds_byte(wc * 32 + fr, fq * 8);
#define PG8_SA(b, h) (((b) * 2 + (h)) * HTB)
#define PG8_SB(b, h) ((4 + (b) * 2 + (h)) * HTB)
#define PG8_STAGE(bufoff, gbase, voff) do { _Pragma("unroll") for (int _i = 0; _i < 2; ++_i) \
        __builtin_amdgcn_global_load_lds((const unsigned*)((const char*)(gbase) + (voff)[_i]), (PG8_LAS unsigned*)(lds + (bufoff) + ldsw + _i * 8192), 16, 0, 0); } while (0)
#define PG8_LDA(dst, b, h) do { _Pragma("unroll") for (int m = 0; m < 4; ++m) _Pragma("unroll") for (int k = 0; k < 2; ++k) dst[m][k] = *(const PG8_LAS bf16x8*)(lds + PG8_SA(b, h) + aoff + m * 2048 + k * 1024); } while (0)
#define PG8_LDB(dst, b, h) do { _Pragma("unroll") for (int n = 0; n < 2; ++n) _Pragma("unroll") for (int k = 0; k < 2; ++k) dst[n][k] = *(const PG8_LAS bf16x8*)(lds + PG8_SB(b, h) + boff + n * 2048 + k * 1024); } while (0)
#define PG8_MMA(ai, bj, At, Bt) do { __builtin_amdgcn_s_setprio(1); _Pragma("unroll") for (int m = 0; m < 4; ++m) _Pragma("unroll") for (int n = 0; n < 2; ++n) _Pragma("unroll") for (int k = 0; k < 2; ++k) \
        acc[ai][bj][m][n] = __builtin_amdgcn_mfma_f32_16x16x32_bf16(Bt[n][k], At[m][k], acc[ai][bj][m][n], 0, 0, 0); __builtin_amdgcn_s_setprio(0); } while (0)
#define PG8_WAIT_V(n) asm volatile("s_waitcnt vmcnt(" #n ")" ::: "memory")
#define PG8_WAIT_L(n) asm volatile("s_waitcnt lgkmcnt(" #n ")" ::: "memory")
#define PG8_BAR __builtin_amdgcn_s_barrier()
#define PG8_SCHED __builtin_amdgcn_sched_barrier(0)
    Unit cur, nxt; int ui = 0;
    if (!S.next(0, cur)) return;
    f32x4 acc[2][2][4][2];
#pragma unroll
    for (int a = 0; a < 2; ++a)
#pragma unroll
        for (int b = 0; b < 2; ++b)
#pragma unroll
            for (int m = 0; m < 4; ++m)
#pragma unroll
                for (int n = 0; n < 2; ++n) acc[a][b][m][n] = (f32x4){0.f, 0.f, 0.f, 0.f};
    bf16x8 At[4][2], B0[2][2], B1[2][2];
    const char* cA = (const char*)g.A + (size_t)cur.pm * tstep; const char* cB = (const char*)g.Bt + (size_t)cur.pn * tstep;
    S.a_ready(cur);
    if constexpr (SP2) {
        PG8_STAGE(PG8_SB(0, 0), cB, voffB); PG8_STAGE(PG8_SB(0, 1), cB + hstep, voffB); PG8_STAGE(PG8_SA(0, 0), cA, voffA); PG8_STAGE(PG8_SA(0, 1), cA + hstep, voffA);
        if (wr == 1) PG8_BAR;
        PG8_WAIT_V(2); PG8_BAR;
        PG8_STAGE(PG8_SB(1, 0), cB + kstep, voffB); PG8_STAGE(PG8_SA(1, 0), cA + kstep, voffA); PG8_STAGE(PG8_SB(1, 1), cB + hstep + kstep, voffB);
        PG8_WAIT_V(6); PG8_BAR;
    } else {
        PG8_STAGE(PG8_SB(0, 0), cB, voffB); PG8_STAGE(PG8_SA(0, 0), cA, voffA); PG8_STAGE(PG8_SB(0, 1), cB + hstep, voffB); PG8_STAGE(PG8_SA(0, 1), cA + hstep, voffA);
        if (wr == 1) PG8_BAR;
        PG8_WAIT_V(4); PG8_BAR;
        PG8_STAGE(PG8_SB(1, 0), cB + kstep, voffB); PG8_STAGE(PG8_SA(1, 0), cA + kstep, voffA); PG8_STAGE(PG8_SB(1, 1), cB + hstep + kstep, voffB);
        PG8_WAIT_V(6); PG8_BAR;
    }
    for (;;) {
        const bool has_next = S.next(ui + 1, nxt);
        const char* nA = has_next ? (const char*)g.A + (size_t)nxt.pm * tstep : cA; const char* nB = has_next ? (const char*)g.Bt + (size_t)nxt.pn * tstep : cB;
        for (int t = 0; t < nt; t += 2) {
            const bool last = (t == nt - 2);
            const char* a1 = cA + (size_t)(t + 1) * kstep;
            const char* a2 = last ? nA : cA + (size_t)(t + 2) * kstep; const char* b2 = last ? nB : cB + (size_t)(t + 2) * kstep;
            const char* a3 = a2 + kstep; const char* b3 = b2 + kstep;
            if (last && has_next) S.a_ready(nxt);
            if constexpr (SP2) {
            PG8_LDB(B0, 0, 0); PG8_LDB(B1, 0, 1); PG8_SCHED; PG8_LDA(At, 0, 0); PG8_STAGE(PG8_SA(1, 1), a1 + hstep, voffA);
            PG8_WAIT_V(8); PG8_WAIT_L(0); PG8_BAR; PG8_MMA(0, 0, At, B0); PG8_MMA(0, 1, At, B1); PG8_BAR; PG8_SCHED;
            PG8_LDA(At, 0, 1); PG8_STAGE(PG8_SB(0, 0), b2, voffB); PG8_STAGE(PG8_SB(0, 1), b2 + hstep, voffB); PG8_STAGE(PG8_SA(0, 0), a2, voffA);
            PG8_WAIT_V(8); PG8_WAIT_L(0); PG8_BAR; PG8_MMA(1, 0, At, B0); PG8_MMA(1, 1, At, B1); PG8_BAR; PG8_SCHED;
            PG8_LDB(B0, 1, 0); PG8_LDB(B1, 1, 1); PG8_SCHED; PG8_LDA(At, 1, 0); PG8_STAGE(PG8_SA(0, 1), a2 + hstep, voffA);
            PG8_WAIT_V(8); PG8_WAIT_L(0); PG8_BAR; PG8_MMA(0, 0, At, B0); PG8_MMA(0, 1, At, B1); PG8_BAR; PG8_SCHED;
            PG8_LDA(At, 1, 1); PG8_STAGE(PG8_SB(1, 0), b3, voffB); PG8_STAGE(PG8_SB(1, 1), b3 + hstep, voffB); PG8_STAGE(PG8_SA(1, 0), a3, voffA);
            PG8_WAIT_V(8); PG8_WAIT_L(0); PG8_BAR; PG8_MMA(1, 0, At, B0); PG8_MMA(1, 1, At, B1); PG8_BAR; PG8_SCHED;
            } else {
            PG8_LDB(B0, 0, 0); PG8_SCHED; PG8_LDA(At, 0, 0); PG8_STAGE(PG8_SA(1, 1), a1 + hstep, voffA);
            PG8_WAIT_L(8); PG8_BAR; PG8_WAIT_L(0); PG8_MMA(0, 0, At, B0); PG8_BAR; PG8_SCHED;
            PG8_LDB(B1, 0, 1); PG8_STAGE(PG8_SB(0, 0), b2, voffB);
            PG8_BAR; PG8_WAIT_L(0); PG8_MMA(0, 1, At, B1); PG8_BAR;
            PG8_LDA(At, 0, 1); PG8_STAGE(PG8_SA(0, 0), a2, voffA);
            PG8_BAR; PG8_WAIT_L(0); PG8_MMA(1, 0, At, B0); PG8_BAR; PG8_SCHED;
            PG8_STAGE(PG8_SB(0, 1), b2 + hstep, voffB);
            PG8_WAIT_V(6); PG8_BAR; PG8_MMA(1, 1, At, B1); PG8_BAR;
            PG8_LDB(B0, 1, 0); PG8_SCHED; PG8_LDA(At, 1, 0); PG8_STAGE(PG8_SA(0, 1), a2 + hstep, voffA);
            PG8_WAIT_L(8); PG8_BAR; PG8_WAIT_L(0); PG8_MMA(0, 0, At, B0); PG8_BAR; PG8_SCHED;
            PG8_LDB(B1, 1, 1); PG8_STAGE(PG8_SB(1, 0), b3, voffB);
            PG8_BAR; PG8_WAIT_L(0); PG8_MMA(0, 1, At, B1); PG8_BAR;
            PG8_LDA(At, 1, 1); PG8_STAGE(PG8_SA(1, 0), a3, voffA);
            PG8_BAR; PG8_WAIT_L(0); PG8_MMA(1, 0, At, B0); PG8_BAR; PG8_SCHED;
            PG8_STAGE(PG8_SB(1, 1), b3 + hstep, voffB);
            PG8_WAIT_V(6); PG8_BAR; PG8_MMA(1, 1, At, B1); PG8_BAR;
            }
        }
        if constexpr (ALIGN_EPI) { if (wr == 0) PG8_BAR; }
        if constexpr (!Epi::AFTER_DRAIN) { E(acc, cur, wr, wc, fr, fq); S.done(cur); }
        if (!has_next) break;
#pragma unroll
        for (int a = 0; a < 2; ++a)
#pragma unroll
            for (int b = 0; b < 2; ++b)
#pragma unroll
                for (int m = 0; m < 4; ++m)
#pragma unroll
                    for (int n = 0; n < 2; ++n) acc[a][b][m][n] = (f32x4){0.f, 0.f, 0.f, 0.f};
        cur = nxt; cA = nA; cB = nB; ++ui;
        if constexpr (ALIGN_EPI) { if (wr == 1) PG8_BAR; }
    }
    PG8_WAIT_V(0);
    if constexpr (!ALIGN_EPI) { if (wr == 0) PG8_BAR; }
    PG8_BAR;
    if constexpr (Epi::AFTER_DRAIN) { E.fused(acc, cur, wr, wc, fr, fq, lds, wid, lane); S.done(cur); }
#undef PG8_SA
#undef PG8_SB
#undef PG8_STAGE
#undef PG8_LDA
#undef PG8_LDB
#undef PG8_MMA
#undef PG8_WAIT_V
#undef PG8_WAIT_L
#undef PG8_BAR
#undef PG8_SCHED
}
}

#define LAS __attribute__((address_space(3)))
typedef unsigned short bf16;
typedef float f32x4 __attribute__((ext_vector_type(4)));
typedef float f32x2 __attribute__((ext_vector_type(2)));
typedef short bf16x8 __attribute__((ext_vector_type(8)));
typedef unsigned u32x4 __attribute__((ext_vector_type(4)));
typedef unsigned u32x2 __attribute__((ext_vector_type(2)));

constexpr int D = 1024, SEQ = 8192, NB = 2, NMETA = 16, MMAIN = NB * SEQ, MPAD = MMAIN + 256, DIN = 1792, DFF = 4096, NLAYER = 2;
constexpr int C_POOL = 0, C_BVAL = 256, C_BGATE = 512, C_CGATE = 768, C_CX = 1280;
constexpr int DRNN = 512, DCONV = 256, DPOOL = 256, CONVK = 31;
constexpr float EPS = 1e-6f;
constexpr int NWAVES = 8, NTHR = 512;

constexpr size_t MiB = 1u << 20;
constexpr size_t WS_CTL = 0, CTL_ZERO_BYTES = 16384;
constexpr size_t WS_PART = 1 * MiB;
constexpr size_t WS_AGG = 3 * MiB;
constexpr size_t WS_HMETA = 5 * MiB;
constexpr size_t WS_SMALLW = 6 * MiB;
constexpr size_t WS_WIN = 7 * MiB, WS_WOUT = 14 * MiB, WS_WUP = 18 * MiB, WS_WDN = 34 * MiB;
constexpr size_t WS_HB = 50 * MiB;
constexpr size_t WS_BIG = 83 * MiB;
constexpr size_t WS_P = WS_BIG, WS_Y = 140 * MiB, WS_GP = 173 * MiB, WS_END = 213 * MiB;
static_assert(WS_P + (size_t)MPAD * DIN * 2 <= WS_Y && WS_Y + (size_t)MPAD * D * 2 <= WS_GP && WS_GP + (size_t)MPAD * DRNN * 2 <= WS_END && WS_BIG + (size_t)MPAD * DFF * 2 <= WS_END, "ws map");
static_assert(WS_HB + (size_t)MPAD * D * 2 <= WS_BIG, "ws map hb");
constexpr size_t SMALLW_LAYER = 512 * 1024;
constexpr size_t SW_POOL = 0, SW_PW = 32 * 1024, SW_WA = 160 * 1024, SW_WX = 224 * 1024;
constexpr size_t AG_SP = 0, AG_SH = AG_SP + NB * 128 * 512, AG_TP = AG_SH + NB * 128 * 512, AG_TH = AG_TP + NB * 32 * 512, AG_MP = AG_TH + NB * 32 * 512, AG_MH = AG_MP + 512;

constexpr int LDS_BYTES = 147456;
constexpr int ASTRIDE = 544;
constexpr int L_V = 0, L_CA = 0;
constexpr int L_G = 49152, L_PA = 49152;
constexpr int L_W = 98304;
constexpr int L_STATS = 131072;
constexpr int XCSTRIDE = 272, L_XC = 0;
constexpr int L_AGG = 0;
constexpr int L_BARST = LDS_BYTES - 256;
static_assert(L_STATS + 1024 <= L_BARST && L_XC + 256 * XCSTRIDE <= L_BARST && 64 * ASTRIDE <= 49152, "lds map");

__device__ __forceinline__ float bf_lo(unsigned u) { return __uint_as_float(u << 16); }
__device__ __forceinline__ float bf_hi(unsigned u) { return __uint_as_float(u & 0xffff0000u); }
__device__ __forceinline__ unsigned pk_bf16(float lo, float hi) { return pg8::cvt_pk_bf16(lo, hi); }
__device__ __forceinline__ float sigm(float x) { return __builtin_amdgcn_rcpf(1.0f + __expf(-x)); }
__device__ __forceinline__ float gelu_tanh(float x) { return x * sigm(1.5957691216f * (x + 0.044715f * x * x * x)); }
__device__ __forceinline__ float wave_sum(float v) {
#pragma unroll
    for (int o = 1; o < 64; o <<= 1) v += __shfl_xor(v, o);
    return v;
}
template <int N> __device__ __forceinline__ float dpp_shr(float old, float x) {
    return __builtin_bit_cast(float, __builtin_amdgcn_update_dpp(__builtin_bit_cast(int, old), __builtin_bit_cast(int, x), 0x110 + N, 0xF, 0xF, false));
}
__device__ __forceinline__ int row_of(int b, int q) { return q < NMETA ? MMAIN + q : b * SEQ + q - NMETA; }

struct Ctx {
    const float* in[23]; float* out; unsigned char* ws;
};

template <bool RELU2> struct EpiScale {
    static constexpr bool PERM = true, AFTER_DRAIN = false;
    bf16* O; int ldc; const float* part;
    __device__ __forceinline__ void operator()(const pg8::f32x4 (&acc)[2][2][4][2], const pg8::Unit& u, int wr, int wc, int fr, int fq) const {
        const int row0 = u.pm * 256 + wr * 64 + fr, col0 = u.pn * 256 + wc * 32 + 8 * fq;
        const int lane = fr + 16 * fq;
        float rsl[2];
#pragma unroll
        for (int ai = 0; ai < 2; ++ai) { const f32x4* pp = (const f32x4*)(part + (size_t)(u.pm * 256 + ai * 128 + wr * 64 + lane) * 16);
            const f32x4 s4 = (pp[0] + pp[1]) + (pp[2] + pp[3]);
            rsl[ai] = __builtin_amdgcn_rsqf(((s4.x + s4.y) + (s4.z + s4.w)) * (1.0f / D) + EPS); }
        asm volatile("" ::: "memory");
#pragma unroll
        for (int ai = 0; ai < 2; ++ai)
#pragma unroll
            for (int m = 0; m < 4; ++m) {
                const int row = row0 + ai * 128 + m * 16;
                const float rs = __shfl(rsl[ai], 16 * m + fr);
                bf16* rowp = O + (size_t)row * ldc + col0;
#pragma unroll
                for (int bj = 0; bj < 2; ++bj) {
                    f32x4 v0 = acc[ai][bj][m][0] * rs, v1 = acc[ai][bj][m][1] * rs;
                    if (RELU2) {
#pragma unroll
                        for (int j = 0; j < 4; ++j) { const float a0 = fmaxf(v0[j], 0.f), a1 = fmaxf(v1[j], 0.f); v0[j] = a0 * a0; v1[j] = a1 * a1; }
                    }
                    u32x4 w; w.x = pk_bf16(v0[0], v0[1]); w.y = pk_bf16(v0[2], v0[3]); w.z = pk_bf16(v1[0], v1[1]); w.w = pk_bf16(v1[2], v1[3]);
                    *(u32x4*)(rowp + bj * 128) = w;
                }
            }
    }
};
struct EpiResid {
    static constexpr bool PERM = true, AFTER_DRAIN = false;
    bf16* hb; float* part;
    __device__ __forceinline__ void operator()(const pg8::f32x4 (&acc)[2][2][4][2], const pg8::Unit& u, int wr, int wc, int fr, int fq) const {
        const int row0 = u.pm * 256 + wr * 64 + fr, col0 = u.pn * 256 + wc * 32 + 8 * fq;
#pragma unroll
        for (int ai = 0; ai < 2; ++ai)
#pragma unroll
            for (int m = 0; m < 4; ++m) {
                const int row = row0 + ai * 128 + m * 16;
                bf16* brow = hb + (size_t)row * D + col0;
                const u32x4 h0 = *(const u32x4*)(brow), h1 = *(const u32x4*)(brow + 128);
                float ss = 0.f;
#pragma unroll
                for (int bj = 0; bj < 2; ++bj) {
                    const u32x4 hr = bj ? h1 : h0;
                    const f32x4 r0 = (f32x4){bf_lo(hr.x), bf_hi(hr.x), bf_lo(hr.y), bf_hi(hr.y)}, r1 = (f32x4){bf_lo(hr.z), bf_hi(hr.z), bf_lo(hr.w), bf_hi(hr.w)};
                    const f32x4 v0 = acc[ai][bj][m][0] + r0, v1 = acc[ai][bj][m][1] + r1;
                    u32x4 w; w.x = pk_bf16(v0[0], v0[1]); w.y = pk_bf16(v0[2], v0[3]); w.z = pk_bf16(v1[0], v1[1]); w.w = pk_bf16(v1[2], v1[3]);
                    *(u32x4*)(brow + bj * 128) = w;
                    ss += (v0[0] * v0[0] + v0[1] * v0[1]) + (v0[2] * v0[2] + v0[3] * v0[3]) + (v1[0] * v1[0] + v1[1] * v1[1]) + (v1[2] * v1[2] + v1[3] * v1[3]);
                }
                ss += __shfl_xor(ss, 16); ss += __shfl_xor(ss, 32);
                if (fq == 0) part[(size_t)row * 16 + u.pn * 4 + wc] = ss;
                if (m & 1) asm volatile("" ::: "memory");
            }
    }
};

template <int MODE  >
__device__ __forceinline__ void skinny_task(const bf16* A, const bf16* Bt, int K, int task, bf16* O, int ldo, float* part, LAS unsigned char* lds) {
    const int tid = pg8::opaque_tid(), wid = __builtin_amdgcn_readfirstlane(tid >> 6), lane = tid & 63, fr = lane & 15, fq = lane >> 4;
    const int n0 = task * 64, kw = K / 8, k0 = wid * kw;
    pg8::f32x4 acc[4];
#pragma unroll
    for (int n = 0; n < 4; ++n) acc[n] = (pg8::f32x4){0.f, 0.f, 0.f, 0.f};
    const bf16* ap = A + (size_t)fr * K + k0 + 8 * fq; const bf16* bp = Bt + (size_t)(n0 + fr) * K + k0 + 8 * fq;
#pragma unroll 4
    for (int k = 0; k < kw; k += 32) {
        const bf16x8 a = *(const bf16x8*)(ap + k);
#pragma unroll
        for (int n = 0; n < 4; ++n) { const bf16x8 bf = *(const bf16x8*)(bp + (size_t)(16 * n) * K + k); acc[n] = __builtin_amdgcn_mfma_f32_16x16x32_bf16(bf, a, acc[n], 0, 0, 0); }
    }
    LAS f32x4* red = (LAS f32x4*)lds;
#pragma unroll
    for (int n = 0; n < 4; ++n) red[(wid * 4 + n) * 64 + lane] = (f32x4){acc[n][0], acc[n][1], acc[n][2], acc[n][3]};
    __syncthreads();
    if (wid == 0) {
        f32x4 sv[4];
#pragma unroll
        for (int n = 0; n < 4; ++n) { sv[n] = red[n * 64 + lane];
#pragma unroll
            for (int w = 1; w < 8; ++w) sv[n] += red[(w * 4 + n) * 64 + lane]; }
        const int row = MMAIN + fr;
        if (MODE < 2) {
            const f32x4* pp = (const f32x4*)(part + (size_t)row * 16);
            const f32x4 s4 = (pp[0] + pp[1]) + (pp[2] + pp[3]);
            const float rs = __builtin_amdgcn_rsqf(((s4.x + s4.y) + (s4.z + s4.w)) * (1.0f / D) + EPS);
#pragma unroll
            for (int n = 0; n < 4; ++n) { f32x4 v = sv[n] * rs;
                if (MODE == 1) {
#pragma unroll
                    for (int j = 0; j < 4; ++j) { const float a0 = fmaxf(v[j], 0.f); v[j] = a0 * a0; } }
                u32x2 w; w.x = pk_bf16(v[0], v[1]); w.y = pk_bf16(v[2], v[3]);
                *(u32x2*)(O + (size_t)row * ldo + n0 + 16 * n + 4 * fq) = w; }
        } else {
            float ss = 0.f;
#pragma unroll
            for (int n = 0; n < 4; ++n) { bf16* op = O + (size_t)row * ldo + n0 + 16 * n + 4 * fq; const u32x2 hr = *(const u32x2*)op;
                const f32x4 v = sv[n] + (f32x4){bf_lo(hr.x), bf_hi(hr.x), bf_lo(hr.y), bf_hi(hr.y)};
                u32x2 w; w.x = pk_bf16(v[0], v[1]); w.y = pk_bf16(v[2], v[3]); *(u32x2*)op = w;
                ss += (v[0] * v[0] + v[1] * v[1]) + (v[2] * v[2] + v[3] * v[3]); }
            ss += __shfl_xor(ss, 16); ss += __shfl_xor(ss, 32);
            if (fq == 0) part[(size_t)row * 16 + task] = ss;
        }
    }
    __syncthreads();
}

__device__ __forceinline__ void p0_transpose_item(const float* W, int K, int N, bf16* WT, const float* gk, LAS float* scr, int item, int lane) {
    const int nblk = N / 32, kb = item / nblk, nb = item % nblk, k0 = 64 * kb, n0 = 32 * nb;
#pragma unroll 8
    for (int i = 0; i < 32; ++i) { const int kk = 2 * i + (lane >> 5); float v = W[(size_t)(k0 + kk) * N + n0 + (lane & 31)]; if (gk) v *= gk[k0 + kk]; scr[kk * 33 + (lane & 31)] = v; }
    asm volatile("s_waitcnt lgkmcnt(0)" ::: "memory");
    const int c = lane & 7;
#pragma unroll
    for (int j = 0; j < 4; ++j) { const int n = (lane >> 3) + 8 * j; const LAS float* s = scr + (8 * c) * 33 + n;
        u32x4 o; o.x = pk_bf16(s[0 * 33], s[1 * 33]); o.y = pk_bf16(s[2 * 33], s[3 * 33]); o.z = pk_bf16(s[4 * 33], s[5 * 33]); o.w = pk_bf16(s[6 * 33], s[7 * 33]);
        *(u32x4*)(WT + (size_t)(n0 + n) * K + k0 + 8 * c) = o; }
    asm volatile("s_waitcnt lgkmcnt(0)" ::: "memory");
}
__device__ __forceinline__ void p0_prologue(const Ctx& C, LAS unsigned char* lds) {
    const int tid = pg8::opaque_tid(), lane = tid & 63, wave = tid >> 6;
    LAS float* scr = (LAS float*)(lds + wave * 16384);
    const int gw = blockIdx.x * NWAVES + wave, NGW = gridDim.x * NWAVES;
    constexpr int I_IN = 16 * 56, I_OUT = 16 * 32, I_UP = 16 * 128, I_DN = 64 * 32, I_POOL = 4 * 2, I_PW = 4 * 8, I_WA = 8 * 2, I_WX = 8 * 2;
    constexpr int I_LAYER = I_IN + I_OUT + I_UP + I_DN + I_POOL + I_PW + I_WA + I_WX;
    unsigned char* ws = C.ws;
    for (int it = gw; it < NLAYER * I_LAYER; it += NGW) {
        const int l = it / I_LAYER; int r = it % I_LAYER;
        bf16* sw = (bf16*)(ws + WS_SMALLW + l * SMALLW_LAYER);
        if (r < I_IN) { p0_transpose_item(C.in[3] + (size_t)l * D * DIN, D, DIN, (bf16*)(ws + WS_WIN) + (size_t)l * D * DIN, C.in[2] + l * D, scr, r, lane); continue; } r -= I_IN;
        if (r < I_OUT) { p0_transpose_item(C.in[18] + (size_t)l * D * D, D, D, (bf16*)(ws + WS_WOUT) + (size_t)l * D * D, nullptr, scr, r, lane); continue; } r -= I_OUT;
        if (r < I_UP) { p0_transpose_item(C.in[20] + (size_t)l * D * DFF, D, DFF, (bf16*)(ws + WS_WUP) + (size_t)l * D * DFF, C.in[19] + l * D, scr, r, lane); continue; } r -= I_UP;
        if (r < I_DN) { p0_transpose_item(C.in[21] + (size_t)l * DFF * D, DFF, D, (bf16*)(ws + WS_WDN) + (size_t)l * DFF * D, nullptr, scr, r, lane); continue; } r -= I_DN;
        if (r < I_POOL) { const int g = r >> 1; p0_transpose_item(C.in[4] + (size_t)(l * 4 + g) * 4096, 64, 64, sw + SW_POOL / 2 + g * 4096, nullptr, scr, r & 1, lane); continue; } r -= I_POOL;
        if (r < I_PW) { p0_transpose_item(C.in[10] + (size_t)l * 65536, 256, 256, sw + SW_PW / 2, nullptr, scr, r, lane); continue; } r -= I_PW;
        if (r < I_WA) { const int h = r >> 1; p0_transpose_item(C.in[13] + (size_t)(l * 8 + h) * 4096, 64, 64, sw + SW_WA / 2 + h * 4096, nullptr, scr, r & 1, lane); continue; } r -= I_WA;
        { const int h = r >> 1; p0_transpose_item(C.in[15] + (size_t)(l * 8 + h) * 4096, 64, 64, sw + SW_WX / 2 + h * 4096, nullptr, scr, r & 1, lane); }
    }
    bf16* hb = (bf16*)(ws + WS_HB); float* part = (float*)(ws + WS_PART);
    for (int m = gw; m < MMAIN + NMETA; m += NGW) {
        f32x4 v[4];
        const float* src = m < MMAIN ? C.in[0] + (size_t)m * D : C.in[1] + (size_t)(m - MMAIN) * D;
        float s = 0.f;
#pragma unroll
        for (int j = 0; j < 4; ++j) { v[j] = ((const f32x4*)src)[lane + 64 * j]; s += (v[j].x * v[j].x + v[j].y * v[j].y) + (v[j].z * v[j].z + v[j].w * v[j].w); }
        s = wave_sum(s);
#pragma unroll
        for (int j = 0; j < 4; ++j) { u32x2 w; w.x = pk_bf16(v[j].x, v[j].y); w.y = pk_bf16(v[j].z, v[j].w); ((u32x2*)(hb + (size_t)m * D))[lane + 64 * j] = w; }
        if (lane < 16) part[(size_t)m * 16 + lane] = lane == 0 ? s : 0.f;
    }
}

template <int CTRL> __device__ __forceinline__ float dpp_mov(float x) {
    return __builtin_bit_cast(float, __builtin_amdgcn_update_dpp(0, __builtin_bit_cast(int, x), CTRL, 0xF, 0xF, true));
}
__device__ __forceinline__ float wave_sum_fast(float v) {
    v += dpp_mov<0xB1>(v); v += dpp_mov<0x4E>(v); v += dpp_mov<0x141>(v); v += dpp_mov<0x140>(v);
    v += __shfl_xor(v, 16); v += __shfl_xor(v, 32);
    return v;
}
__device__ __forceinline__ void convpool_item(const Ctx& C, int l, int b, int pos0, int nvalid, LAS unsigned char* lds) {
    const int tid = pg8::opaque_tid(), lane = tid & 63, wid = __builtin_amdgcn_readfirstlane(tid >> 6), fr = lane & 15, fq = lane >> 4;
    const int cp = (wid & 1) * 64 + lane, tg = wid >> 1;
    const bf16* P = (const bf16*)(C.ws + WS_P); bf16* Y = (bf16*)(C.ws + WS_Y);
    const bf16* sw = (const bf16*)(C.ws + WS_SMALLW + l * SMALLW_LAYER);
    const bool act = tg * 16 < nvalid;
    const int nrows = nvalid + 30;
    const int pg = wid & 3, pth = wid >> 2, pch = 64 * pg + lane;
    const bool pact = pth * 32 < nvalid;
    float xr[47];
    if (pact) {
#pragma unroll
        for (int i = 0; i < 47; ++i) { const int q = pos0 + pth * 32 - 15 + i; const unsigned v = *(const unsigned short*)(P + (size_t)row_of(b, max(q, 0)) * DIN + C_POOL + pch); xr[i] = q >= 0 ? __uint_as_float(v << 16) : 0.f; }
    }
#pragma unroll 1
    for (int pi = wid; pi < 127; pi += NWAVES) {
        const char* gp; int loff;
        if (pi < 96) { const int isg = pi >= 48, pr = (isg ? pi - 48 : pi) * 2 + (lane >> 5); const int q = pos0 - 30 + pr;
            gp = (const char*)(P + (size_t)row_of(b, max(q, 0)) * DIN + (isg ? C_BGATE : C_BVAL) + (lane & 31) * 8); loff = (isg ? L_G : L_V) + (pr & ~1) * 512; }
        else { const int k = pi - 96; gp = (const char*)(C.in[6] + ((size_t)l * CONVK + k) * DCONV + lane * 4); loff = L_W + k * 1024; }
        __builtin_amdgcn_global_load_lds((const unsigned*)gp, (LAS unsigned*)(lds + __builtin_amdgcn_readfirstlane(loff)), 16, 0, 0);
    }
    if (tid < 256) *(LAS float*)(lds + L_W + 31 * 1024 + tid * 4) = 0.f;
    const f32x2 bias = *(const f32x2*)(C.in[7] + l * DCONV + 2 * cp);
    const f32x2 lg = *(const f32x2*)(C.in[8] + l * DCONV + 2 * cp), lb = *(const f32x2*)(C.in[9] + l * DCONV + 2 * cp);
    asm volatile("s_waitcnt vmcnt(0)" ::: "memory");
    __syncthreads();
#pragma unroll 2
    for (int i = 0; i < 24; ++i) { const int r = tg + 4 * i; const int q = pos0 - 30 + r;
        const unsigned vv = *(const LAS unsigned*)(lds + L_V + r * 512 + cp * 4), gg = *(const LAS unsigned*)(lds + L_G + r * 512 + cp * 4);
        const bool ok = q >= 0 && r < nrows;
        *(LAS unsigned*)(lds + L_V + r * 512 + cp * 4) = ok ? pk_bf16(bf_lo(vv) * sigm(bf_lo(gg)), bf_hi(vv) * sigm(bf_hi(gg))) : 0u; }
    __syncthreads();
    if (pact) {
#define POOL_BODY(W) do { float sum = 0.f; \
        _Pragma("unroll") for (int d = 1; d < (W); ++d) sum += xr[15 - d]; \
        _Pragma("unroll") for (int j = 0; j < 32; ++j) { const int i = j + 15; sum += xr[i]; \
            const int q = pos0 + pth * 32 + j; const float inv = __builtin_amdgcn_rcpf((float)min(q + 1, (W))); const float o = sum * inv - xr[i]; \
            *(LAS unsigned short*)(lds + L_PA + (pth * 32 + j) * ASTRIDE + pch * 2) = (unsigned short)(pk_bf16(o, 0.f) & 0xffffu); \
            sum -= xr[i - (W) + 1]; } } while (0)
        if (pg == 0) POOL_BODY(2); else if (pg == 1) POOL_BODY(4); else if (pg == 2) POOL_BODY(8); else POOL_BODY(16);
#undef POOL_BODY
    }
    f32x2 acc[16];
    if (act) {
#pragma unroll
        for (int j = 0; j < 16; ++j) acc[j] = bias;
#pragma unroll 1
        for (int kc = 0; kc < 8; ++kc) {
            f32x2 w4[4], u[19];
#pragma unroll
            for (int t = 0; t < 4; ++t) w4[t] = *(const LAS f32x2*)(lds + L_W + (4 * kc + t) * 1024 + cp * 8);
#pragma unroll
            for (int i = 0; i < 19; ++i) { const unsigned uu = *(const LAS unsigned*)(lds + L_V + (tg * 16 + 4 * kc + i) * 512 + cp * 4); u[i] = (f32x2){bf_lo(uu), bf_hi(uu)}; }
#pragma unroll
            for (int j = 0; j < 16; ++j)
#pragma unroll
                for (int t = 0; t < 4; ++t) acc[j] += w4[t] * u[j + t];
        }
#pragma unroll
        for (int j = 0; j < 16; ++j) {
            const float s1 = wave_sum_fast(acc[j].x + acc[j].y), sq = wave_sum_fast(acc[j].x * acc[j].x + acc[j].y * acc[j].y);
            if (lane == 0) *(LAS f32x2*)(lds + L_STATS + ((tg * 16 + j) * 2 + (wid & 1)) * 8) = (f32x2){s1, sq};
        }
    }
    const int n0 = 32 * wid, g4 = wid >> 1, d0 = n0 & 63;
    const bf16* pwt = sw + SW_PW / 2; const bf16* plt = sw + SW_POOL / 2 + g4 * 4096;
    bf16x8 Bp[8][2], Bq[2][2];
#pragma unroll
    for (int kk = 0; kk < 8; ++kk)
#pragma unroll
        for (int n = 0; n < 2; ++n) Bp[kk][n] = *(const bf16x8*)(pwt + (size_t)(n0 + 16 * n + fr) * 256 + 32 * kk + 8 * fq);
#pragma unroll
    for (int kk = 0; kk < 2; ++kk)
#pragma unroll
        for (int n = 0; n < 2; ++n) Bq[kk][n] = *(const bf16x8*)(plt + (size_t)(d0 + 16 * n + fr) * 64 + 32 * kk + 8 * fq);
    __syncthreads();
    if (act) {
#pragma unroll
        for (int j = 0; j < 16; ++j) {
            const f32x4 st = *(LAS f32x4*)(lds + L_STATS + (tg * 16 + j) * 16);
            const float mean = (st.x + st.z) * (1.0f / DCONV), var = fmaxf((st.y + st.w) * (1.0f / DCONV) - mean * mean, 0.f), rstd = __builtin_amdgcn_rsqf(var + EPS);
            f32x2 y = (acc[j] - mean) * rstd * lg + lb;
            y.x = y.x * sigm(y.x); y.y = y.y * sigm(y.y);
            *(LAS unsigned*)(lds + L_CA + (tg * 16 + j) * ASTRIDE + cp * 4) = pk_bf16(y.x, y.y);
        }
    }
    __syncthreads();
    {
        pg8::f32x4 accb[4][2], acca[4][2];
#pragma unroll
        for (int m = 0; m < 4; ++m)
#pragma unroll
            for (int n = 0; n < 2; ++n) { accb[m][n] = (pg8::f32x4){0.f, 0.f, 0.f, 0.f}; acca[m][n] = (pg8::f32x4){0.f, 0.f, 0.f, 0.f}; }
#pragma unroll
        for (int kk = 0; kk < 8; ++kk) {
#pragma unroll
            for (int m = 0; m < 4; ++m) { if (16 * m >= nvalid) continue; const bf16x8 Af = *(const LAS bf16x8*)(lds + L_CA + (16 * m + fr) * ASTRIDE + (32 * kk + 8 * fq) * 2);
#pragma unroll
                for (int n = 0; n < 2; ++n) accb[m][n] = __builtin_amdgcn_mfma_f32_16x16x32_bf16(Bp[kk][n], Af, accb[m][n], 0, 0, 0); }
        }
#pragma unroll
        for (int kk = 0; kk < 2; ++kk) {
#pragma unroll
            for (int m = 0; m < 4; ++m) { if (16 * m >= nvalid) continue; const bf16x8 Af = *(const LAS bf16x8*)(lds + L_PA + (16 * m + fr) * ASTRIDE + (64 * g4 + 32 * kk + 8 * fq) * 2);
#pragma unroll
                for (int n = 0; n < 2; ++n) acca[m][n] = __builtin_amdgcn_mfma_f32_16x16x32_bf16(Bq[kk][n], Af, acca[m][n], 0, 0, 0); }
        }
        const float* psc = C.in[5] + l * DPOOL;
        f32x4 sc[2];
#pragma unroll
        for (int n = 0; n < 2; ++n) sc[n] = *(const f32x4*)(psc + n0 + 16 * n + 4 * fq);
#pragma unroll
        for (int m = 0; m < 4; ++m) { const int tok = 16 * m + fr;
            if (tok < nvalid) { bf16* yr = Y + (size_t)row_of(b, pos0 + tok) * D;
#pragma unroll
                for (int n = 0; n < 2; ++n) { const int col = n0 + 16 * n + 4 * fq;
                    const pg8::f32x4 a = acca[m][n], c = accb[m][n];
                    u32x2 wa; wa.x = pk_bf16(a[0] * sc[n].x, a[1] * sc[n].y); wa.y = pk_bf16(a[2] * sc[n].z, a[3] * sc[n].w);
                    u32x2 wb; wb.x = pk_bf16(c[0], c[1]); wb.y = pk_bf16(c[2], c[3]);
                    *(u32x2*)(yr + col) = wa; *(u32x2*)(yr + DPOOL + col) = wb; } } }
    }
    __syncthreads();
}

__device__ __forceinline__ void rg_item(const Ctx& C, int l, int b, int pos0, int nvalid, int hp, int tile, LAS unsigned char* lds) {
    const int tid = pg8::opaque_tid(), lane = tid & 63, wid = __builtin_amdgcn_readfirstlane(tid >> 6), fr = lane & 15, fq = lane >> 4;
    const int hsel = wid >> 2, nt = wid & 3, hh = 2 * hp + hsel, cb = 64 * hh, c0 = 16 * nt + 4 * fq, cl = hsel * 64 + c0;
    const bf16* P = (const bf16*)(C.ws + WS_P); bf16* Y = (bf16*)(C.ws + WS_Y); bf16* GPb = (bf16*)(C.ws + WS_GP);
    const bf16* sw = (const bf16*)(C.ws + WS_SMALLW + l * SMALLW_LAYER);
    float* agg = (float*)(C.ws + WS_AGG);
    const int mcnt = (nvalid + 15) >> 4;
    {
        const int cg = tid & 15, tq = tid >> 4, cx = 128 * hp + 8 * cg;
        if (8 * tq < 16 * mcnt) {
            f32x4 wk[4][2];
#pragma unroll
            for (int k = 0; k < 4; ++k) { wk[k][0] = *(const f32x4*)(C.in[11] + (size_t)(l * 4 + k) * DRNN + cx); wk[k][1] = *(const f32x4*)(C.in[11] + (size_t)(l * 4 + k) * DRNN + cx + 4); }
            const f32x4 bs0 = *(const f32x4*)(C.in[12] + l * DRNN + cx), bs1 = *(const f32x4*)(C.in[12] + l * DRNN + cx + 4);
            u32x4 xr[11];
#pragma unroll
            for (int i = 0; i < 11; ++i) { const int q = pos0 + 8 * tq - 3 + i; const u32x4 raw = *(const u32x4*)(P + (size_t)row_of(b, max(q, 0)) * DIN + C_CX + cx); xr[i] = q >= 0 ? raw : (u32x4){0u, 0u, 0u, 0u}; }
#pragma unroll
            for (int t = 0; t < 8; ++t) {
                f32x4 a0 = bs0, a1 = bs1;
#pragma unroll
                for (int k = 0; k < 4; ++k) { const u32x4 raw = xr[t + k];
                    a0 += wk[k][0] * (f32x4){bf_lo(raw.x), bf_hi(raw.x), bf_lo(raw.y), bf_hi(raw.y)};
                    a1 += wk[k][1] * (f32x4){bf_lo(raw.z), bf_hi(raw.z), bf_lo(raw.w), bf_hi(raw.w)}; }
                u32x4 pk; pk.x = pk_bf16(a0.x, a0.y); pk.y = pk_bf16(a0.z, a0.w); pk.z = pk_bf16(a1.x, a1.y); pk.w = pk_bf16(a1.z, a1.w);
                *(LAS u32x4*)(lds + L_XC + (8 * tq + t) * XCSTRIDE + cg * 16) = pk;
            }
        }
    }
    const int cgl = DRNN * l + cb + c0;
    const f32x4 ba = *(const f32x4*)(C.in[14] + cgl), bx = *(const f32x4*)(C.in[16] + cgl), lam = *(const f32x4*)(C.in[17] + cgl);
    f32x4 sp;
#pragma unroll
    for (int v = 0; v < 4; ++v) sp[v] = 8.0f * log1pf(__expf(-lam[v]));
    bf16x8 Ba[2], Bx[2];
#pragma unroll
    for (int kk = 0; kk < 2; ++kk) { const size_t o = (size_t)(hh * 64 + 16 * nt + fr) * 64 + 32 * kk + 8 * fq; Ba[kk] = *(const bf16x8*)(sw + SW_WA / 2 + o); Bx[kk] = *(const bf16x8*)(sw + SW_WX / 2 + o); }
    u32x2 gnext = *(const u32x2*)(P + (size_t)row_of(b, pos0 + fr) * DIN + C_CGATE + cb + c0);
    __syncthreads();
    f32x4 cP = (f32x4){1.f, 1.f, 1.f, 1.f}, cH = (f32x4){0.f, 0.f, 0.f, 0.f};
    const int bsrc = (lane & 48) | 15;
#pragma unroll 1
    for (int m = 0; m < mcnt; ++m) {
        const int tok = 16 * m + fr; const bool valid = tok < nvalid;
        const size_t row = (size_t)row_of(b, pos0 + tok);
        const u32x2 graw = gnext;
        if (m + 1 < mcnt) gnext = *(const u32x2*)(P + (size_t)row_of(b, pos0 + tok + 16) * DIN + C_CGATE + cb + c0);
        pg8::f32x4 ga = (pg8::f32x4){0.f, 0.f, 0.f, 0.f}, gx = (pg8::f32x4){0.f, 0.f, 0.f, 0.f};
#pragma unroll
        for (int kk = 0; kk < 2; ++kk) { const bf16x8 Af = *(const LAS bf16x8*)(lds + L_XC + tok * XCSTRIDE + (hsel * 64 + 32 * kk + 8 * fq) * 2);
            ga = __builtin_amdgcn_mfma_f32_16x16x32_bf16(Ba[kk], Af, ga, 0, 0, 0); gx = __builtin_amdgcn_mfma_f32_16x16x32_bf16(Bx[kk], Af, gx, 0, 0, 0); }
        const u32x2 xraw = *(const LAS u32x2*)(lds + L_XC + tok * XCSTRIDE + cl * 2);
        const f32x4 xc = (f32x4){bf_lo(xraw.x), bf_hi(xraw.x), bf_lo(xraw.y), bf_hi(xraw.y)};
        const f32x4 gt = (f32x4){bf_lo(graw.x), bf_hi(graw.x), bf_lo(graw.y), bf_hi(graw.y)};
        f32x4 Pt, Ht;
#pragma unroll
        for (int v = 0; v < 4; ++v) {
            const float r = sigm(ga[v] + ba[v]), ig = sigm(gx[v] + bx[v]);
            float a = __expf(-r * sp[v]);
            float bb = __builtin_amdgcn_sqrtf(fmaxf(1.0f - a * a, 0.f)) * ig * xc[v];
            if (!valid) { a = 1.0f; bb = 0.0f; }
            { float ap = dpp_shr<1>(1.0f, a), bp = dpp_shr<1>(0.0f, bb); bb = bb + a * bp; a = a * ap; }
            { float ap = dpp_shr<2>(1.0f, a), bp = dpp_shr<2>(0.0f, bb); bb = bb + a * bp; a = a * ap; }
            { float ap = dpp_shr<4>(1.0f, a), bp = dpp_shr<4>(0.0f, bb); bb = bb + a * bp; a = a * ap; }
            { float ap = dpp_shr<8>(1.0f, a), bp = dpp_shr<8>(0.0f, bb); bb = bb + a * bp; a = a * ap; }
            Pt[v] = a * cP[v]; Ht[v] = bb + a * cH[v];
        }
        if (valid) {
            f32x4 G;
#pragma unroll
            for (int v = 0; v < 4; ++v) G[v] = gelu_tanh(gt[v]);
            u32x2 w1; w1.x = pk_bf16(G[0] * Ht[0], G[1] * Ht[1]); w1.y = pk_bf16(G[2] * Ht[2], G[3] * Ht[3]);
            u32x2 w2; w2.x = pk_bf16(G[0] * Pt[0], G[1] * Pt[1]); w2.y = pk_bf16(G[2] * Pt[2], G[3] * Pt[3]);
            *(u32x2*)(Y + row * D + 512 + cb + c0) = w1; *(u32x2*)(GPb + row * DRNN + cb + c0) = w2;
        }
#pragma unroll
        for (int v = 0; v < 4; ++v) { cP[v] = __shfl(Pt[v], bsrc); cH[v] = __shfl(Ht[v], bsrc); }
    }
    if (fr == 0) {
        if (tile >= 0) { const size_t o = ((size_t)b * 32 + tile) * 512 + cb + c0; *(f32x4*)(agg + AG_TP + o) = cP; *(f32x4*)(agg + AG_TH + o) = cH; }
        else { *(f32x4*)(agg + AG_MP + cb + c0) = cP; *(f32x4*)(agg + AG_MH + cb + c0) = cH; }
    }
    __syncthreads();
}

__device__ __forceinline__ void rg_fix_item(const Ctx& C, int b, int tile, int hp) {
    const int tid = pg8::opaque_tid(), lane = tid & 63, wid = __builtin_amdgcn_readfirstlane(tid >> 6);
    const int hsel = wid & 1, s = wid >> 1, c = 64 * (2 * hp + hsel) + 8 * (lane & 7), r8 = lane >> 3;
    bf16* Y = (bf16*)(C.ws + WS_Y); const bf16* GPb = (const bf16*)(C.ws + WS_GP); const float* agg = (const float*)(C.ws + WS_AGG);
    f32x4 H0 = *(const f32x4*)(agg + AG_MH + c), H1 = *(const f32x4*)(agg + AG_MH + c + 4);
#pragma unroll 8
    for (int jj = 0; jj < tile; ++jj) { const size_t o = ((size_t)b * 32 + jj) * 512 + c;
        const f32x4 p0 = *(const f32x4*)(agg + AG_TP + o), p1 = *(const f32x4*)(agg + AG_TP + o + 4), h0 = *(const f32x4*)(agg + AG_TH + o), h1 = *(const f32x4*)(agg + AG_TH + o + 4);
        H0 = h0 + p0 * H0; H1 = h1 + p1 * H1; }
#pragma unroll 8
    for (int it = 0; it < 8; ++it) {
        const size_t row = (size_t)b * SEQ + tile * 256 + 64 * s + 8 * it + r8;
        const u32x4 gh = *(const u32x4*)(Y + row * D + 512 + c), gp = *(const u32x4*)(GPb + row * DRNN + c);
        u32x4 o;
        o.x = pk_bf16(bf_lo(gh.x) + bf_lo(gp.x) * H0.x, bf_hi(gh.x) + bf_hi(gp.x) * H0.y);
        o.y = pk_bf16(bf_lo(gh.y) + bf_lo(gp.y) * H0.z, bf_hi(gh.y) + bf_hi(gp.y) * H0.w);
        o.z = pk_bf16(bf_lo(gh.z) + bf_lo(gp.z) * H1.x, bf_hi(gh.z) + bf_hi(gp.z) * H1.y);
        o.w = pk_bf16(bf_lo(gh.w) + bf_lo(gp.w) * H1.z, bf_hi(gh.w) + bf_hi(gp.w) * H1.w);
        *(u32x4*)(Y + row * D + 512 + c) = o;
    }
}

__device__ __forceinline__ void final_norm(const Ctx& C) {
    const int tid = pg8::opaque_tid(), lane = tid & 63, wave = tid >> 6;
    const int gw = blockIdx.x * NWAVES + wave, NGW = gridDim.x * NWAVES;
    const float* part = (const float*)(C.ws + WS_PART);
    f32x4 g[4];
#pragma unroll
    for (int j = 0; j < 4; ++j) g[j] = ((const f32x4*)C.in[22])[lane + 64 * j];
    for (int m = gw; m < MMAIN; m += NGW) {
        const f32x4* pp = (const f32x4*)(part + (size_t)m * 16);
        const f32x4 s4 = (pp[0] + pp[1]) + (pp[2] + pp[3]);
        const float rs = __builtin_amdgcn_rsqf(((s4.x + s4.y) + (s4.z + s4.w)) * (1.0f / D) + EPS);
        const u32x2* hr = (const u32x2*)((const bf16*)(C.ws + WS_HB) + (size_t)m * D);
        f32x4* o = (f32x4*)(C.out + (size_t)m * D);
#pragma unroll
        for (int j = 0; j < 4; ++j) { const u32x2 h = hr[lane + 64 * j]; o[lane + 64 * j] = (f32x4){bf_lo(h.x), bf_hi(h.x), bf_lo(h.y), bf_hi(h.y)} * rs * g[j]; }
    }
}

#define XB_TMO      128
#define XB_XCNT(j)  (256  + 64 * (j))
#define XB_XSUB(j)  (1280 + 64 * (j))
#define XB_XGEN(j)  (2304 + 64 * (j))
#define XB_TOP      3328
#define XB_TOPGEN   3392
#define XCD_BAR_WORDS 3456
#define XB_SPIN_CAP (1u << 18)

__device__ __forceinline__ unsigned xb_ld(unsigned* p)              { return __hip_atomic_load(p, __ATOMIC_RELAXED, __HIP_MEMORY_SCOPE_AGENT); }
__device__ __forceinline__ unsigned xb_add(unsigned* p, unsigned v) { return __hip_atomic_fetch_add(p, v, __ATOMIC_RELAXED, __HIP_MEMORY_SCOPE_AGENT); }
__device__ __forceinline__ unsigned xb_xcc_id() { return (unsigned)__builtin_amdgcn_s_getreg((3 << 11) | 20) & 0xFu; }
#define XB_SPIN(cond, bar) do { unsigned _sp = 0; while (cond) { __builtin_amdgcn_s_sleep(1); \
    if ((++_sp & 255u) == 0u) { if (xb_ld(&(bar)[XB_TMO])) break; if (_sp > XB_SPIN_CAP) { atomicAdd(&(bar)[XB_TMO], 1u); break; } } } } while (0)

struct XcdBarrier {
    unsigned* bar; unsigned x;
    volatile LAS unsigned* st;
};

__device__ __forceinline__ XcdBarrier xcd_barrier_post(unsigned* bar, volatile LAS unsigned* st) {
    XcdBarrier b; b.bar = bar; b.x = xb_xcc_id(); b.st = st;
    if (threadIdx.x == 0) (void)xb_add(&bar[XB_XCNT(b.x)], 1u);
    return b;
}
__device__ __forceinline__ void xcd_barrier_complete(unsigned* bar, unsigned x, unsigned& nloc, unsigned& nx) {
    const unsigned G = gridDim.x * gridDim.y * gridDim.z;
    unsigned sum, cnt, mine, sp = 0u;
    for (;;) {
        sum = 0u; cnt = 0u; mine = 0u;
#pragma unroll
        for (unsigned j = 0; j < 16; ++j) { const unsigned c = xb_ld(&bar[XB_XCNT(j)]); sum += c; cnt += (c > 0u) ? 1u : 0u; mine = (j == x) ? c : mine; }
        if (sum == G) break;
        __builtin_amdgcn_s_sleep(1);
        if ((++sp & 255u) == 0u) { if (xb_ld(&bar[XB_TMO])) break; if (sp > XB_SPIN_CAP) { atomicAdd(&bar[XB_TMO], 1u); break; } }
    }
    nloc = mine > 0u ? mine : 1u; nx = cnt > 0u ? cnt : 1u;
}

__device__ __forceinline__ void xcd_barrier(const XcdBarrier& b) {
    asm volatile("s_waitcnt vmcnt(0)" ::: "memory");
    __syncthreads();
    if (threadIdx.x == 0) {
        unsigned* bar = b.bar;
        __builtin_amdgcn_s_waitcnt(0);
        unsigned nloc = b.st[0], nx = b.st[1];
        if (nloc == 0u) { xcd_barrier_complete(bar, b.x, nloc, nx); b.st[0] = nloc; b.st[1] = nx; }
        const unsigned old = xb_add(&bar[XB_XSUB(b.x)], 1u);
        const unsigned gen = old / nloc;
        if (old + 1u == (gen + 1u) * nloc) {
            __builtin_amdgcn_fence(__ATOMIC_RELEASE, "agent");
            asm volatile("s_waitcnt vmcnt(0)" ::: "memory");
            const unsigned og = xb_add(&bar[XB_TOP], 1u);
            const unsigned tg = og / nx;
            if (og + 1u == (tg + 1u) * nx) xb_add(&bar[XB_TOPGEN], 1u);
            else XB_SPIN(xb_ld(&bar[XB_TOPGEN]) == tg, bar);
            __builtin_amdgcn_fence(__ATOMIC_ACQUIRE, "agent");
            xb_add(&bar[XB_XGEN(b.x)], 1u);
            asm volatile("s_waitcnt vmcnt(0)" ::: "memory");
        } else {
            XB_SPIN(xb_ld(&bar[XB_XGEN(b.x)]) == gen, bar);
            __builtin_amdgcn_fence(__ATOMIC_ACQUIRE, "agent");
            asm volatile("s_waitcnt vmcnt(0)" ::: "memory");
        }
    }
    __syncthreads();
}

constexpr int N_PHASES = 2 + 6 * NLAYER;
struct Args { const float* in[23]; float* out; unsigned char* ws; int ph_lo, ph_hi; };
__global__ void __launch_bounds__(NTHR) hymba_fwd(Args args) {
    extern __shared__ __attribute__((aligned(16))) unsigned char lds_raw[];
    LAS unsigned char* lds = (LAS unsigned char*)lds_raw;
    cg::grid_group grid = cg::this_grid();
    if (args.ph_hi < 0) grid.sync();
    { volatile LAS unsigned* st0 = (volatile LAS unsigned*)(lds + L_BARST); if (threadIdx.x < 16) st0[threadIdx.x] = 0u; }
    __syncthreads();
    XcdBarrier xbar = xcd_barrier_post((unsigned*)(args.ws + WS_CTL), (volatile LAS unsigned*)(lds + L_BARST));
    Ctx C;
#pragma unroll
    for (int i = 0; i < 23; ++i) C.in[i] = args.in[i];
    C.out = args.out; C.ws = args.ws;
    unsigned char* ws = args.ws;
    const int G = gridDim.x;
    bf16* hb = (bf16*)(ws + WS_HB); float* part = (float*)(ws + WS_PART);
#ifndef PROBE_REP
#define PROBE_REP 0
#endif
#ifndef PROBE_SYNCS
#define PROBE_SYNCS 0
#endif
    for (int ph = args.ph_lo; ph < args.ph_hi; ++ph) {
        if (ph > args.ph_lo) xcd_barrier(xbar);
        if (PROBE_SYNCS && ph == 1) for (int e = 0; e < PROBE_SYNCS; ++e) xcd_barrier(xbar);
        const int pkind = ph == 0 ? 0 : (ph == N_PHASES - 1 ? 7 : 1 + (ph - 1) % 6);
        const int nrep = 1 + ((PROBE_REP >> pkind) & 1);
        for (int rep = 0; rep < nrep; ++rep) {
#ifndef NO_P0
        if (ph == 0) { p0_prologue(C, lds); continue; }
#endif
        if (ph == N_PHASES - 1) { final_norm(C); continue; }
        const int l = (ph - 1) / 6, k = (ph - 1) % 6;
#ifndef NO_GEMM
        if (k == 0) {
            const bf16* Wt = (const bf16*)(ws + WS_WIN) + (size_t)l * D * DIN;
            pg8::Gemm g{hb, Wt, MMAIN, DIN, D}; pg8::StaticOrder S; S.init(MMAIN, DIN, G, (int)blockIdx.x);
            EpiScale<false> E{(bf16*)(ws + WS_P), DIN, part};
#ifndef NO_GA
            pg8::gemm_phase<EpiScale<false>, pg8::StaticOrder, true, true>(lds, g, S, E);
#endif
            for (int t = G - 1 - (int)blockIdx.x; t < DIN / 64; t += G) skinny_task<0>(hb + (size_t)MMAIN * D, Wt, D, t, (bf16*)(ws + WS_P), DIN, part, lds);
        } else
#endif
        if (k == 1) {
            for (int r2 = 0; r2 <= ((PROBE_REP >> 8) & 1); ++r2)
            for (int it = blockIdx.x; it < 257; it += G) {
#ifndef NO_CP
                if (it < 256) convpool_item(C, l, it >> 7, NMETA + 64 * (it & 127), 64, lds);
                else convpool_item(C, l, 0, 0, NMETA, lds);
#endif
            }
            for (int r2 = 0; r2 <= ((PROBE_REP >> 9) & 1); ++r2)
            for (int it = blockIdx.x; it < 260; it += G) {
#ifndef NO_RG
                if (it < 256) rg_item(C, l, it >> 7, NMETA + 256 * ((it >> 2) & 31), 256, it & 3, (it >> 2) & 31, lds);
                else rg_item(C, l, 0, 0, NMETA, it - 256, -1, lds);
#endif
            }
        } else if (k == 2) {
            for (int it = blockIdx.x; it < 256; it += G) rg_fix_item(C, it >> 7, (it >> 2) & 31, it & 3);
        }
#ifndef NO_GEMM
        else if (k == 3) {
            const bf16* Wt = (const bf16*)(ws + WS_WOUT) + (size_t)l * D * D;
            pg8::Gemm g{(const bf16*)(ws + WS_Y), Wt, MMAIN, D, D}; pg8::StaticOrder S; S.init(MMAIN, D, G, (int)blockIdx.x);
            EpiResid E{hb, part};
#ifndef NO_GC
            pg8::gemm_phase<EpiResid, pg8::StaticOrder, true, true>(lds, g, S, E);
#endif
            for (int t = blockIdx.x; t < D / 64; t += G) skinny_task<2>((const bf16*)(ws + WS_Y) + (size_t)MMAIN * D, Wt, D, t, hb, D, part, lds);
        } else if (k == 4) {
            const bf16* Wt = (const bf16*)(ws + WS_WUP) + (size_t)l * D * DFF;
            pg8::Gemm g{hb, Wt, MMAIN, DFF, D}; pg8::StaticOrder S; S.init(MMAIN, DFF, G, (int)blockIdx.x);
            EpiScale<true> E{(bf16*)(ws + WS_BIG), DFF, part};
#ifndef NO_GD
            pg8::gemm_phase<EpiScale<true>, pg8::StaticOrder, true, true>(lds, g, S, E);
#endif
            for (int t = blockIdx.x; t < DFF / 64; t += G) skinny_task<1>(hb + (size_t)MMAIN * D, Wt, D, t, (bf16*)(ws + WS_BIG), DFF, part, lds);
        } else {
            const bf16* Wt = (const bf16*)(ws + WS_WDN) + (size_t)l * DFF * D;
            pg8::Gemm g{(const bf16*)(ws + WS_BIG), Wt, MMAIN, D, DFF}; pg8::StaticOrder S; S.init(MMAIN, D, G, (int)blockIdx.x);
            EpiResid E{hb, part};
#ifndef NO_GE
            pg8::gemm_phase<EpiResid, pg8::StaticOrder, true, true>(lds, g, S, E);
#endif
            for (int t = blockIdx.x; t < D / 64; t += G) skinny_task<2>((const bf16*)(ws + WS_BIG) + (size_t)MMAIN * DFF, Wt, DFF, t, hb, D, part, lds);
        }
#endif
        }
    }
}

extern "C" void kernel_launch(void* const* d_in, const int* in_sizes, int n_in, void* d_out, int out_size, void* d_ws, size_t ws_size, hipStream_t stream) {
    static int grid = 0;
    if (grid == 0) {
        if (n_in != 23 || out_size != MMAIN * D || ws_size < WS_END) { fprintf(stderr, "kernel_launch: unexpected shapes (n_in %d out %d ws %zu)\n", n_in, out_size, ws_size); grid = -1; return; }
        int dev = 0, cus = 0, per_cu = 0;
        hipGetDevice(&dev); hipDeviceGetAttribute(&cus, hipDeviceAttributeMultiprocessorCount, dev);
        hipFuncSetAttribute((const void*)hymba_fwd, hipFuncAttributeMaxDynamicSharedMemorySize, LDS_BYTES);
        hipOccupancyMaxActiveBlocksPerMultiprocessor(&per_cu, (const void*)hymba_fwd, NTHR, LDS_BYTES);
        if (per_cu < 1) per_cu = 1;
        (void)hipGetLastError();
        grid = cus;
    }
    if (grid < 0) return;
    if (hipMemsetAsync((char*)d_ws + WS_CTL, 0, CTL_ZERO_BYTES, stream) != hipSuccess) { fprintf(stderr, "kernel_launch: memset failed\n"); return; }
    Args a{};
    for (int i = 0; i < 23; ++i) a.in[i] = (const float*)d_in[i];
    a.out = (float*)d_out; a.ws = (unsigned char*)d_ws; a.ph_lo = 0; a.ph_hi = N_PHASES;
    void* kargs[] = {&a};
    hipError_t e = hipLaunchCooperativeKernel((const void*)hymba_fwd, dim3(grid), dim3(NTHR), kargs, LDS_BYTES, stream);
    if (e != hipSuccess) fprintf(stderr, "kernel_launch: cooperative launch failed: %s (grid %d)\n", hipGetErrorString(e), grid);
}
```

```cpp
#include <hip/hip_runtime.h>
#include <hip/hip_cooperative_groups.h>
#include <cstdio>
#include <cstdint>
namespace cg = cooperative_groups;
namespace pg8 {
#define PG8_LAS __attribute__((address_space(3)))
typedef unsigned short bf16_t;
typedef short bf16x8 __attribute__((ext_vector_type(8)));
typedef float f32x4 __attribute__((ext_vector_type(4)));
typedef unsigned u32x4 __attribute__((ext_vector_type(4)));
constexpr int BM = 256, BK = 64, HALF = 128, HTB = HALF * BK * 2  , STAGE_BYTES = 8 * HTB, NXCD = 8, WGM = 8;

__host__ __device__ __forceinline__ int lds_byte(int r, int c) { const int st = (r >> 4) * 2 + (c >> 5), rr = r & 15, cc = c & 31, ob = rr * 64 + cc * 2; return st * 1024 + (ob ^ (((ob >> 9) & 1) << 5)); }
__host__ __device__ __forceinline__ void stage_rc(int b, int& R, int& C) { const int st = b / 1024, sb = b % 1024, swz = sb ^ (((sb >> 9) & 1) << 5); R = (st >> 1) * 16 + swz / 64; C = (st & 1) * 32 + (swz % 64) / 2; }
__host__ __device__ __forceinline__ int perm32(int rho) { const int n = rho >> 4, i = rho & 15; return 8 * (i >> 2) + 4 * n + (i & 3); }

__device__ __forceinline__ int opaque_tid() { int t = threadIdx.x; asm volatile("" : "+v"(t)); return t; }
struct Unit { int pm, pn; };
struct Gemm { const bf16_t* A; const bf16_t* Bt; int M, N, K; };

struct StaticOrder {
    int nM, nN, nwg, G, c;
    __host__ __device__ void init(int M, int N, int G_, int c_) { nM = M / BM; nN = N / BM; nwg = nM * nN; G = G_; c = c_; }
    __host__ __device__ bool next(int i, Unit& u) const {
        const long L = (long)i * G + c; if (L >= nwg) return false;
        int wgid = (int)L; { const int q = nwg / NXCD, r = nwg % NXCD, xcd = wgid % NXCD, off = wgid / NXCD; wgid = (xcd < r ? xcd * (q + 1) : r * (q + 1) + (xcd - r) * q) + off; }
        const int nig = WGM * nN, gid = wgid / nig, fm = gid * WGM, gsz = (nM - fm) < WGM ? (nM - fm) : WGM;
        u.pm = fm + ((wgid % nig) % gsz); u.pn = (wgid % nig) / gsz; return true;
    }
    __device__ __forceinline__ void a_ready(const Unit&) const {}
    __device__ __forceinline__ void done(const Unit&) const {}
};
__device__ __forceinline__ unsigned cvt_pk_bf16(float lo, float hi) { unsigned r; asm volatile("v_cvt_pk_bf16_f32 %0, %1, %2" : "=v"(r) : "v"(lo), "v"(hi)); return r; }
template <class Epi, class Sched, bool ALIGN_EPI = false, bool SP2 = false>
__device__ __forceinline__ void gemm_phase(PG8_LAS unsigned char* lds, const Gemm g, const Sched& S, const Epi& E) {
    const int tid = opaque_tid(), wid = __builtin_amdgcn_readfirstlane(tid >> 6), lane = tid & 63, wr = wid >> 2, wc = wid & 3, fr = lane & 15, fq = lane >> 4;
    const int K = g.K, nt = K / BK;
    unsigned voffA[2], voffB[2];
#pragma unroll
    for (int i = 0; i < 2; ++i) { int R, C; stage_rc(tid * 16 + i * 8192, R, C); const int Rb = Epi::PERM ? ((R & ~31) + perm32(R & 31)) : R;
        voffA[i] = (unsigned)(R * K + C) * 2u; voffB[i] = (unsigned)(Rb * K + C) * 2u; }
    const size_t kstep = (size_t)(BK * 2);
    const size_t hstep = (size_t)HALF * K * 2;
    const size_t tstep = 2 * hstep;
    const unsigned ldsw = (unsigned)wid * 1024u;
    const int aoff = lds_byte(wr * 64 + fr, fq * 8), boff = lds_byte(wc * 32 + fr, fq * 8);
#define PG8_SA(b, h) (((b) * 2 + (h)) * HTB)
#define PG8_SB(b, h) ((4 + (b) * 2 + (h)) * HTB)
#define PG8_STAGE(bufoff, gbase, voff) do { _Pragma("unroll") for (int _i = 0; _i < 2; ++_i) \
        __builtin_amdgcn_global_load_lds((const unsigned*)((const char*)(gbase) + (voff)[_i]), (PG8_LAS unsigned*)(lds + (bufoff) + ldsw + _i * 8192), 16, 0, 0); } while (0)
#define PG8_LDA(dst, b, h) do { _Pragma("unroll") for (int m = 0; m < 4; ++m) _Pragma("unroll") for (int k = 0; k < 2; ++k) dst[m][k] = *(const PG8_LAS bf16x8*)(lds + PG8_SA(b, h) + aoff + m * 2048 + k * 1024); } while (0)
#define PG8_LDB(dst, b, h) do { _Pragma("unroll") for (int n = 0; n < 2; ++n) _Pragma("unroll") for (int k = 0; k < 2; ++k) dst[n][k] = *(const PG8_LAS bf16x8*)(lds + PG8_SB(b, h) + boff + n * 2048 + k * 1024); } while (0)
#define PG8_MMA(ai, bj, At, Bt) do { __builtin_amdgcn_s_setprio(1); _Pragma("unroll") for (int m = 0; m < 4; ++m) _Pragma("unroll") for (int n = 0; n < 2; ++n) _Pragma("unroll") for (int k = 0; k < 2; ++k) \
        acc[ai][bj][m][n] = __builtin_amdgcn_mfma_f32_16x16x32_bf16(Bt[n][k], At[m][k], acc[ai][bj][m][n], 0, 0, 0); __builtin_amdgcn_s_setprio(0); } while (0)
#define PG8_WAIT_V(n) asm volatile("s_waitcnt vmcnt(" #n ")" ::: "memory")
#define PG8_WAIT_L(n) asm volatile("s_waitcnt lgkmcnt(" #n ")" ::: "memory")
#define PG8_BAR __builtin_amdgcn_s_barrier()
#define PG8_SCHED __builtin_amdgcn_sched_barrier(0)
    Unit cur, nxt; int ui = 0;
    if (!S.next(0, cur)) return;
    f32x4 acc[2][2][4][2];
#pragma unroll
    for (int a = 0; a < 2; ++a)
#pragma unroll
        for (int b = 0; b < 2; ++b)
#pragma unroll
            for (int m = 0; m < 4; ++m)
#pragma unroll
                for (int n = 0; n < 2; ++n) acc[a][b][m][n] = (f32x4){0.f, 0.f, 0.f, 0.f};
    bf16x8 At[4][2], B0[2][2], B1[2][2];
    const char* cA = (const char*)g.A + (size_t)cur.pm * tstep; const char* cB = (const char*)g.Bt + (size_t)cur.pn * tstep;
    S.a_ready(cur);
    if constexpr (SP2) {
        PG8_STAGE(PG8_SB(0, 0), cB, voffB); PG8_STAGE(PG8_SB(0, 1), cB + hstep, voffB); PG8_STAGE(PG8_SA(0, 0), cA, voffA); PG8_STAGE(PG8_SA(0, 1), cA + hstep, voffA);
        if (wr == 1) PG8_BAR;
        PG8_WAIT_V(2); PG8_BAR;
        PG8_STAGE(PG8_SB(1, 0), cB + kstep, voffB); PG8_STAGE(PG8_SA(1, 0), cA + kstep, voffA); PG8_STAGE(PG8_SB(1, 1), cB + hstep + kstep, voffB);
        PG8_WAIT_V(6); PG8_BAR;
    } else {
        PG8_STAGE(PG8_SB(0, 0), cB, voffB); PG8_STAGE(PG8_SA(0, 0), cA, voffA); PG8_STAGE(PG8_SB(0, 1), cB + hstep, voffB); PG8_STAGE(PG8_SA(0, 1), cA + hstep, voffA);
        if (wr == 1) PG8_BAR;
        PG8_WAIT_V(4); PG8_BAR;
        PG8_STAGE(PG8_SB(1, 0), cB + kstep, voffB); PG8_STAGE(PG8_SA(1, 0), cA + kstep, voffA); PG8_STAGE(PG8_SB(1, 1), cB + hstep + kstep, voffB);
        PG8_WAIT_V(6); PG8_BAR;
    }
    for (;;) {
        const bool has_next = S.next(ui + 1, nxt);
        const char* nA = has_next ? (const char*)g.A + (size_t)nxt.pm * tstep : cA; const char* nB = has_next ? (const char*)g.Bt + (size_t)nxt.pn * tstep : cB;
        for (int t = 0; t < nt; t += 2) {
            const bool last = (t == nt - 2);
            const char* a1 = cA + (size_t)(t + 1) * kstep;
            const char* a2 = last ? nA : cA + (size_t)(t + 2) * kstep; const char* b2 = last ? nB : cB + (size_t)(t + 2) * kstep;
            const char* a3 = a2 + kstep; const char* b3 = b2 + kstep;
            if (last && has_next) S.a_ready(nxt);
            if constexpr (SP2) {
            PG8_LDB(B0, 0, 0); PG8_LDB(B1, 0, 1); PG8_SCHED; PG8_LDA(At, 0, 0); PG8_STAGE(PG8_SA(1, 1), a1 + hstep, voffA);
            PG8_WAIT_V(8); PG8_WAIT_L(0); PG8_BAR; PG8_MMA(0, 0, At, B0); PG8_MMA(0, 1, At, B1); PG8_BAR; PG8_SCHED;
            PG8_LDA(At, 0, 1); PG8_STAGE(PG8_SB(0, 0), b2, voffB); PG8_STAGE(PG8_SB(0, 1), b2 + hstep, voffB); PG8_STAGE(PG8_SA(0, 0), a2, voffA);
            PG8_WAIT_V(8); PG8_WAIT_L(0); PG8_BAR; PG8_MMA(1, 0, At, B0); PG8_MMA(1, 1, At, B1); PG8_BAR; PG8_SCHED;
            PG8_LDB(B0, 1, 0); PG8_LDB(B1, 1, 1); PG8_SCHED; PG8_LDA(At, 1, 0); PG8_STAGE(PG8_SA(0, 1), a2 + hstep, voffA);
            PG8_WAIT_V(8); PG8_WAIT_L(0); PG8_BAR; PG8_MMA(0, 0, At, B0); PG8_MMA(0, 1, At, B1); PG8_BAR; PG8_SCHED;
            PG8_LDA(At, 1, 1); PG8_STAGE(PG8_SB(1, 0), b3, voffB); PG8_STAGE(PG8_SB(1, 1), b3 + hstep, voffB); PG8_STAGE(PG8_SA(1, 0), a3, voffA);
            PG8_WAIT_V(8); PG8_WAIT_L(0); PG8_BAR; PG8_MMA(1, 0, At, B0); PG8_MMA(1, 1, At, B1); PG8_BAR; PG8_SCHED;
            } else {
            PG8_LDB(B0, 0, 0); PG8_SCHED; PG8_LDA(At, 0, 0); PG8_STAGE(PG8_SA(1, 1), a1 + hstep, voffA);
            PG8_WAIT_L(8); PG8_BAR; PG8_WAIT_L(0); PG8_MMA(0, 0, At, B0); PG8_BAR; PG8_SCHED;
            PG8_LDB(B1, 0, 1); PG8_STAGE(PG8_SB(0, 0), b2, voffB);
            PG8_BAR; PG8_WAIT_L(0); PG8_MMA(0, 1, At, B1); PG8_BAR;
            PG8_LDA(At, 0, 1); PG8_STAGE(PG8_SA(0, 0), a2, voffA);
            PG8_BAR; PG8_WAIT_L(0); PG8_MMA(1, 0, At, B0); PG8_BAR; PG8_SCHED;
            PG8_STAGE(PG8_SB(0, 1), b2 + hstep, voffB);
            PG8_WAIT_V(6); PG8_BAR; PG8_MMA(1, 1, At, B1); PG8_BAR;
            PG8_LDB(B0, 1, 0); PG8_SCHED; PG8_LDA(At, 1, 0); PG8_STAGE(PG8_SA(0, 1), a2 + hstep, voffA);
            PG8_WAIT_L(8); PG8_BAR; PG8_WAIT_L(0); PG8_MMA(0, 0, At, B0); PG8_BAR; PG8_SCHED;
            PG8_LDB(B1, 1, 1); PG8_STAGE(PG8_SB(1, 0), b3, voffB);
            PG8_BAR; PG8_WAIT_L(0); PG8_MMA(0, 1, At, B1); PG8_BAR;
            PG8_LDA(At, 1, 1); PG8_STAGE(PG8_SA(1, 0), a3, voffA);
            PG8_BAR; PG8_WAIT_L(0); PG8_MMA(1, 0, At, B0); PG8_BAR; PG8_SCHED;
            PG8_STAGE(PG8_SB(1, 1), b3 + hstep, voffB);
            PG8_WAIT_V(6); PG8_BAR; PG8_MMA(1, 1, At, B1); PG8_BAR;
            }
        }
        if constexpr (ALIGN_EPI) { if (wr == 0) PG8_BAR; }
        if constexpr (!Epi::AFTER_DRAIN) { E(acc, cur, wr, wc, fr, fq); S.done(cur); }
        if (!has_next) break;
#pragma unroll
        for (int a = 0; a < 2; ++a)
#pragma unroll
            for (int b = 0; b < 2; ++b)
#pragma unroll
                for (int m = 0; m < 4; ++m)
#pragma unroll
                    for (int n = 0; n < 2; ++n) acc[a][b][m][n] = (f32x4){0.f, 0.f, 0.f, 0.f};
        cur = nxt; cA = nA; cB = nB; ++ui;
        if constexpr (ALIGN_EPI) { if (wr == 1) PG8_BAR; }
    }
    PG8_WAIT_V(0);
    if constexpr (!ALIGN_EPI) { if (wr == 0) PG8_BAR; }
    PG8_BAR;
    if constexpr (Epi::AFTER_DRAIN) { E.fused(acc, cur, wr, wc, fr, fq, lds, wid, lane); S.done(cur); }
#undef PG8_SA
#undef PG8_SB
#undef PG8_STAGE
#undef PG8_LDA
#undef PG8_LDB
#undef PG8_MMA
#undef PG8_WAIT_V
#undef PG8_WAIT_L
#undef PG8_BAR
#undef PG8_SCHED
}
}

#define LAS __attribute__((address_space(3)))
typedef unsigned short bf16;
typedef float f32x4 __attribute__((ext_vector_type(4)));
typedef float f32x2 __attribute__((ext_vector_type(2)));
typedef short bf16x8 __attribute__((ext_vector_type(8)));
typedef unsigned u32x4 __attribute__((ext_vector_type(4)));
typedef unsigned u32x2 __attribute__((ext_vector_type(2)));

constexpr int D = 1024, SEQ = 8192, NB = 2, NMETA = 16, MMAIN = NB * SEQ, DIN = 1792, DFF = 4096, NLAYER = 2;
constexpr int C_POOL = 0, C_BVAL = 256, C_BGATE = 512, C_CGATE = 768, C_CX = 1280;
constexpr int DRNN = 512, DCONV = 256, DPOOL = 256, CONVK = 31;
constexpr float EPS = 1e-6f;
constexpr int NWAVES = 8, NTHR = 512;

constexpr size_t MiB = 1u << 20;
constexpr int NROWS = MMAIN + NMETA;
constexpr size_t WS_CTL = 0, CTL_ZERO_BYTES = 65536;
constexpr size_t WS_AGG = 65536;
constexpr size_t WS_PART = 640 * 1024;
constexpr size_t WS_SMALLW = WS_PART + 1088 * 1024;
constexpr size_t SMALLW_LAYER = 288 * 1024;
constexpr size_t SW_POOL = 0, SW_PW = 32 * 1024, SW_WA = 160 * 1024, SW_WX = 224 * 1024;
constexpr size_t WS_WIN = 3 * MiB, WS_WOUT = 10 * MiB, WS_WUP = 14 * MiB, WS_WDN = 30 * MiB;
constexpr size_t WS_HB = 46 * MiB;
constexpr size_t WS_HID = WS_HB + (size_t)NROWS * D * 2 + 4096;
constexpr size_t WS_Y = WS_HID + (size_t)NROWS * DFF * 2 + 4096;
constexpr size_t WS_GP = WS_Y + (size_t)NROWS * D * 2 + 4096;
constexpr size_t WS_END = WS_GP + (size_t)MMAIN * DRNN * 2;
static_assert(WS_END <= 256 * MiB && WS_SMALLW + NLAYER * SMALLW_LAYER <= WS_WIN && WS_PART + (size_t)NROWS * 64 <= WS_SMALLW, "ws map");
static_assert((size_t)NROWS * DIN * 2 <= (size_t)MMAIN * D * 4, "p fits d_out");
constexpr size_t AG_TP = 0, AG_TH = AG_TP + NB * 32 * 512, AG_MP = AG_TH + NB * 32 * 512, AG_MH = AG_MP + 512, AG_LAYER = AG_MH + 512;
static_assert(WS_AGG + NLAYER * AG_LAYER * 4 <= WS_PART, "agg fits");
constexpr int CW_SEAM = 4096, CW_META = CW_SEAM + NLAYER * 4 * 64 * 16;
static_assert((CW_META + NLAYER * 4 * 16) * 4 <= (int)CTL_ZERO_BYTES, "ctl words");
__device__ __forceinline__ unsigned* seam_cnt(unsigned char* ws, int l, int sm, int pm) { return (unsigned*)(ws + WS_CTL) + CW_SEAM + ((l * 4 + sm) * 64 + pm) * 16; }
__device__ __forceinline__ unsigned* meta_cnt(unsigned char* ws, int l, int j) { return (unsigned*)(ws + WS_CTL) + CW_META + (l * 4 + j) * 16; }

constexpr int LDS_BYTES = 147456;
constexpr int ASTRIDE = 544;
constexpr int L_V = 0, L_CA = 0;
constexpr int L_G = 49152, L_PA = 49152;
constexpr int L_W = 98304;
constexpr int L_STATS = 131072;
constexpr int XCSTRIDE = 272, L_XC = 0;
constexpr int L_AGG = 0;
constexpr int L_BARST = LDS_BYTES - 256;
static_assert(L_STATS + 1024 <= L_BARST && L_XC + 256 * XCSTRIDE <= L_BARST && 64 * ASTRIDE <= 49152, "lds map");

__device__ __forceinline__ float bf_lo(unsigned u) { return __uint_as_float(u << 16); }
__device__ __forceinline__ float bf_hi(unsigned u) { return __uint_as_float(u & 0xffff0000u); }
__device__ __forceinline__ unsigned pk_bf16(float lo, float hi) { return pg8::cvt_pk_bf16(lo, hi); }
__device__ __forceinline__ void st16_wt(void* p, u32x4 v) { asm volatile("global_store_dwordx4 %0, %1, off sc1\n\ts_nop 1" :: "v"(p), "v"(v) : "memory"); }
__device__ __forceinline__ float sigm(float x) { return __builtin_amdgcn_rcpf(1.0f + __expf(-x)); }
__device__ __forceinline__ float gelu_tanh(float x) { return x * sigm(1.5957691216f * (x + 0.044715f * x * x * x)); }
__device__ __forceinline__ float wave_sum(float v) {
#pragma unroll
    for (int o = 1; o < 64; o <<= 1) v += __shfl_xor(v, o);
    return v;
}
template <int N> __device__ __forceinline__ float dpp_shr(float old, float x) {
    return __builtin_bit_cast(float, __builtin_amdgcn_update_dpp(__builtin_bit_cast(int, old), __builtin_bit_cast(int, x), 0x110 + N, 0xF, 0xF, false));
}
__device__ __forceinline__ int row_of(int b, int q) { return q < NMETA ? MMAIN + q : b * SEQ + q - NMETA; }

struct Ctx {
    const float* in[23]; float* out; unsigned char* ws;
};

template <bool RELU2> struct EpiScale {
    static constexpr bool PERM = true, AFTER_DRAIN = false;
    bf16* O; int ldc; const float* part;
    __device__ __forceinline__ void operator()(const pg8::f32x4 (&acc)[2][2][4][2], const pg8::Unit& u, int wr, int wc, int fr, int fq) const {
        const int row0 = u.pm * 256 + wr * 64 + fr, col0 = u.pn * 256 + wc * 32 + 8 * fq;
        const int lane = fr + 16 * fq;
        float rsl[2];
#pragma unroll
        for (int ai = 0; ai < 2; ++ai) { const f32x4* pp = (const f32x4*)(part + (size_t)(u.pm * 256 + ai * 128 + wr * 64 + lane) * 16);
            const f32x4 s4 = (pp[0] + pp[1]) + (pp[2] + pp[3]);
            rsl[ai] = __builtin_amdgcn_rsqf(((s4.x + s4.y) + (s4.z + s4.w)) * (1.0f / D) + EPS); }
        asm volatile("" ::: "memory");
#pragma unroll
        for (int ai = 0; ai < 2; ++ai)
#pragma unroll
            for (int m = 0; m < 4; ++m) {
                const int row = row0 + ai * 128 + m * 16;
                const float rs = __shfl(rsl[ai], 16 * m + fr);
                bf16* rowp = O + (size_t)row * ldc + col0;
#pragma unroll
                for (int bj = 0; bj < 2; ++bj) {
                    f32x4 v0 = acc[ai][bj][m][0] * rs, v1 = acc[ai][bj][m][1] * rs;
                    if (RELU2) {
#pragma unroll
                        for (int j = 0; j < 4; ++j) { const float a0 = fmaxf(v0[j], 0.f), a1 = fmaxf(v1[j], 0.f); v0[j] = a0 * a0; v1[j] = a1 * a1; }
                    }
                    u32x4 w; w.x = pk_bf16(v0[0], v0[1]); w.y = pk_bf16(v0[2], v0[3]); w.z = pk_bf16(v1[0], v1[1]); w.w = pk_bf16(v1[2], v1[3]);
                    st16_wt(rowp + bj * 128, w);
                }
            }
    }
};
struct EpiResid {
    static constexpr bool PERM = true, AFTER_DRAIN = false;
    const bf16* hin; bf16* hb; float* part;
    __device__ __forceinline__ void operator()(const pg8::f32x4 (&acc)[2][2][4][2], const pg8::Unit& u, int wr, int wc, int fr, int fq) const {
        const int row0 = u.pm * 256 + wr * 64 + fr, col0 = u.pn * 256 + wc * 32 + 8 * fq;
#pragma unroll
        for (int ai = 0; ai < 2; ++ai)
#pragma unroll
            for (int m = 0; m < 4; ++m) {
                const int row = row0 + ai * 128 + m * 16;
                bf16* brow = hb + (size_t)row * D + col0; const bf16* irow = hin + (size_t)row * D + col0;
                const u32x4 h0 = *(const u32x4*)(irow), h1 = *(const u32x4*)(irow + 128);
                float ss = 0.f;
#pragma unroll
                for (int bj = 0; bj < 2; ++bj) {
                    const u32x4 hr = bj ? h1 : h0;
                    const f32x4 r0 = (f32x4){bf_lo(hr.x), bf_hi(hr.x), bf_lo(hr.y), bf_hi(hr.y)}, r1 = (f32x4){bf_lo(hr.z), bf_hi(hr.z), bf_lo(hr.w), bf_hi(hr.w)};
                    const f32x4 v0 = acc[ai][bj][m][0] + r0, v1 = acc[ai][bj][m][1] + r1;
                    u32x4 w; w.x = pk_bf16(v0[0], v0[1]); w.y = pk_bf16(v0[2], v0[3]); w.z = pk_bf16(v1[0], v1[1]); w.w = pk_bf16(v1[2], v1[3]);
                    st16_wt(brow + bj * 128, w);
                    ss += (v0[0] * v0[0] + v0[1] * v0[1]) + (v0[2] * v0[2] + v0[3] * v0[3]) + (v1[0] * v1[0] + v1[1] * v1[1]) + (v1[2] * v1[2] + v1[3] * v1[3]);
                }
                ss += __shfl_xor(ss, 16); ss += __shfl_xor(ss, 32);
                if (fq == 0) part[(size_t)row * 16 + u.pn * 4 + wc] = ss;
                if (m & 1) asm volatile("" ::: "memory");
            }
    }
};

template <int MODE  >
__device__ __forceinline__ void skinny_task(const bf16* A, const bf16* Bt, int K, int task, bf16* O, int ldo, float* part, LAS unsigned char* lds) {
    const int tid = pg8::opaque_tid(), wid = __builtin_amdgcn_readfirstlane(tid >> 6), lane = tid & 63, fr = lane & 15, fq = lane >> 4;
    const int n0 = task * 64, kw = K / 8, k0 = wid * kw;
    pg8::f32x4 acc[4];
#pragma unroll
    for (int n = 0; n < 4; ++n) acc[n] = (pg8::f32x4){0.f, 0.f, 0.f, 0.f};
    const bf16* ap = A + (size_t)fr * K + k0 + 8 * fq; const bf16* bp = Bt + (size_t)(n0 + fr) * K + k0 + 8 * fq;
#pragma unroll 4
    for (int k = 0; k < kw; k += 32) {
        const bf16x8 a = *(const bf16x8*)(ap + k);
#pragma unroll
        for (int n = 0; n < 4; ++n) { const bf16x8 bf = *(const bf16x8*)(bp + (size_t)(16 * n) * K + k); acc[n] = __builtin_amdgcn_mfma_f32_16x16x32_bf16(bf, a, acc[n], 0, 0, 0); }
    }
    LAS f32x4* red = (LAS f32x4*)lds;
#pragma unroll
    for (int n = 0; n < 4; ++n) red[(wid * 4 + n) * 64 + lane] = (f32x4){acc[n][0], acc[n][1], acc[n][2], acc[n][3]};
    __syncthreads();
    if (wid == 0) {
        f32x4 sv[4];
#pragma unroll
        for (int n = 0; n < 4; ++n) { sv[n] = red[n * 64 + lane];
#pragma unroll
            for (int w = 1; w < 8; ++w) sv[n] += red[(w * 4 + n) * 64 + lane]; }
        const int row = MMAIN + fr;
        if (MODE < 2) {
            const f32x4* pp = (const f32x4*)(part + (size_t)row * 16);
            const f32x4 s4 = (pp[0] + pp[1]) + (pp[2] + pp[3]);
            const float rs = __builtin_amdgcn_rsqf(((s4.x + s4.y) + (s4.z + s4.w)) * (1.0f / D) + EPS);
#pragma unroll
            for (int n = 0; n < 4; ++n) { f32x4 v = sv[n] * rs;
                if (MODE == 1) {
#pragma unroll
                    for (int j = 0; j < 4; ++j) { const float a0 = fmaxf(v[j], 0.f); v[j] = a0 * a0; } }
                u32x2 w; w.x = pk_bf16(v[0], v[1]); w.y = pk_bf16(v[2], v[3]);
                *(u32x2*)(O + (size_t)row * ldo + n0 + 16 * n + 4 * fq) = w; }
        } else {
            float ss = 0.f;
#pragma unroll
            for (int n = 0; n < 4; ++n) { bf16* op = O + (size_t)row * ldo + n0 + 16 * n + 4 * fq; const u32x2 hr = *(const u32x2*)op;
                const f32x4 v = sv[n] + (f32x4){bf_lo(hr.x), bf_hi(hr.x), bf_lo(hr.y), bf_hi(hr.y)};
                u32x2 w; w.x = pk_bf16(v[0], v[1]); w.y = pk_bf16(v[2], v[3]); *(u32x2*)op = w;
                ss += (v[0] * v[0] + v[1] * v[1]) + (v[2] * v[2] + v[3] * v[3]); }
            ss += __shfl_xor(ss, 16); ss += __shfl_xor(ss, 32);
            if (fq == 0) part[(size_t)row * 16 + task] = ss;
        }
    }
    __syncthreads();
}

struct TrItem { const float* W; bf16* WT; const float* gk; int K, N, item; };
__device__ __forceinline__ void tr_load(const TrItem& t, int lane, f32x4 (&tv)[8]) {
    const int nblk = t.N / 32, kb = t.item / nblk, nb = t.item % nblk, k0 = 64 * kb, n0 = 32 * nb;
#pragma unroll
    for (int i = 0; i < 8; ++i) { const int kk = 8 * i + (lane >> 3); tv[i] = *(const f32x4*)(t.W + (size_t)(k0 + kk) * t.N + n0 + 4 * (lane & 7)); if (t.gk) tv[i] = tv[i] * t.gk[k0 + kk]; }
}
__device__ __forceinline__ void tr_store(const TrItem& t, int lane, const f32x4 (&tv)[8], LAS float* scr) {
    const int nblk = t.N / 32, kb = t.item / nblk, nb = t.item % nblk, k0 = 64 * kb, n0 = 32 * nb;
#pragma unroll
    for (int i = 0; i < 8; ++i) { const int kk = 8 * i + (lane >> 3); LAS float* d = scr + kk * 33 + 4 * (lane & 7); d[0] = tv[i].x; d[1] = tv[i].y; d[2] = tv[i].z; d[3] = tv[i].w; }
    asm volatile("s_waitcnt lgkmcnt(0)" ::: "memory");
    const int c = lane & 7;
#pragma unroll
    for (int j = 0; j < 4; ++j) { const int n = (lane >> 3) + 8 * j; const LAS float* sp = scr + (8 * c) * 33 + n;
        u32x4 o; o.x = pk_bf16(sp[0 * 33], sp[1 * 33]); o.y = pk_bf16(sp[2 * 33], sp[3 * 33]); o.z = pk_bf16(sp[4 * 33], sp[5 * 33]); o.w = pk_bf16(sp[6 * 33], sp[7 * 33]);
        *(u32x4*)(t.WT + (size_t)(n0 + n) * t.K + k0 + 8 * c) = o; }
    asm volatile("s_waitcnt lgkmcnt(0)" ::: "memory");
}
constexpr int I_IN = 16 * 56, I_OUT = 16 * 32, I_UP = 16 * 128, I_DN = 64 * 32, I_POOL = 4 * 2, I_PW = 4 * 8, I_WA = 8 * 2, I_WX = 8 * 2;
constexpr int I_LAYER = I_IN + I_OUT + I_UP + I_DN + I_POOL + I_PW + I_WA + I_WX;
__device__ __forceinline__ TrItem tr_desc(const Ctx& C, int l, int r) {
    unsigned char* ws = C.ws; bf16* sw = (bf16*)(ws + WS_SMALLW + l * SMALLW_LAYER);
    if (r < I_IN) return TrItem{C.in[3] + (size_t)l * D * DIN, (bf16*)(ws + WS_WIN) + (size_t)l * D * DIN, C.in[2] + l * D, D, DIN, r}; r -= I_IN;
    if (r < I_OUT) return TrItem{C.in[18] + (size_t)l * D * D, (bf16*)(ws + WS_WOUT) + (size_t)l * D * D, nullptr, D, D, r}; r -= I_OUT;
    if (r < I_UP) return TrItem{C.in[20] + (size_t)l * D * DFF, (bf16*)(ws + WS_WUP) + (size_t)l * D * DFF, C.in[19] + l * D, D, DFF, r}; r -= I_UP;
    if (r < I_DN) return TrItem{C.in[21] + (size_t)l * DFF * D, (bf16*)(ws + WS_WDN) + (size_t)l * DFF * D, nullptr, DFF, D, r}; r -= I_DN;
    if (r < I_POOL) { const int g = r >> 1; return TrItem{C.in[4] + (size_t)(l * 4 + g) * 4096, sw + SW_POOL / 2 + g * 4096, nullptr, 64, 64, r & 1}; } r -= I_POOL;
    if (r < I_PW) return TrItem{C.in[10] + (size_t)l * 65536, sw + SW_PW / 2, nullptr, 256, 256, r}; r -= I_PW;
    if (r < I_WA) { const int h = r >> 1; return TrItem{C.in[13] + (size_t)(l * 8 + h) * 4096, sw + SW_WA / 2 + h * 4096, nullptr, 64, 64, r & 1}; } r -= I_WA;
    { const int h = r >> 1; return TrItem{C.in[15] + (size_t)(l * 8 + h) * 4096, sw + SW_WX / 2 + h * 4096, nullptr, 64, 64, r & 1}; }
}
__device__ __forceinline__ void p0_prologue(const Ctx& C, LAS unsigned char* lds, int l_lo, int l_hi, int rows, int vb, int nb) {
    const int tid = pg8::opaque_tid(), lane = tid & 63, wave = tid >> 6;
    LAS float* scr = (LAS float*)(lds + wave * 16384);
    const int gw = vb * NWAVES + wave, NGW = nb * NWAVES;
    unsigned char* ws = C.ws;
    const int nit = (l_hi - l_lo) * I_LAYER;
#pragma unroll 1
    for (int it = gw; it < nit; it += 2 * NGW) {
        const int it2 = it + NGW; const bool two = it2 < nit;
        const TrItem ta = tr_desc(C, l_lo + it / I_LAYER, it % I_LAYER), tb = tr_desc(C, l_lo + (two ? it2 : it) / I_LAYER, (two ? it2 : it) % I_LAYER);
        f32x4 va[8], vb8[8];
        tr_load(ta, lane, va); if (two) tr_load(tb, lane, vb8);
        tr_store(ta, lane, va, scr); if (two) tr_store(tb, lane, vb8, scr);
    }
    bf16* hb = (bf16*)(ws + WS_HB); float* part = (float*)(ws + WS_PART);
    if (rows) for (int m0 = gw; m0 < MMAIN + NMETA; m0 += 2 * NGW) {
        f32x4 v[2][4]; float sq[2];
#pragma unroll
        for (int u = 0; u < 2; ++u) { const int m = m0 + u * NGW; if (m < MMAIN + NMETA) {
            const float* src = m < MMAIN ? C.in[0] + (size_t)m * D : C.in[1] + (size_t)(m - MMAIN) * D;
#pragma unroll
            for (int j = 0; j < 4; ++j) v[u][j] = ((const f32x4*)src)[lane + 64 * j]; } }
#pragma unroll
        for (int u = 0; u < 2; ++u) { const int m = m0 + u * NGW; if (m < MMAIN + NMETA) {
            float s = 0.f;
#pragma unroll
            for (int j = 0; j < 4; ++j) s += (v[u][j].x * v[u][j].x + v[u][j].y * v[u][j].y) + (v[u][j].z * v[u][j].z + v[u][j].w * v[u][j].w);
            sq[u] = wave_sum(s);
#pragma unroll
            for (int j = 0; j < 4; ++j) { u32x2 w; w.x = pk_bf16(v[u][j].x, v[u][j].y); w.y = pk_bf16(v[u][j].z, v[u][j].w); ((u32x2*)(hb + (size_t)m * D))[lane + 64 * j] = w; }
            if (lane < 16) part[(size_t)m * 16 + lane] = lane == 0 ? sq[u] : 0.f; } }
    }
}

template <int CTRL> __device__ __forceinline__ float dpp_mov(float x) {
    return __builtin_bit_cast(float, __builtin_amdgcn_update_dpp(0, __builtin_bit_cast(int, x), CTRL, 0xF, 0xF, true));
}
__device__ __forceinline__ float wave_sum_fast(float v) {
    v += dpp_mov<0xB1>(v); v += dpp_mov<0x4E>(v); v += dpp_mov<0x141>(v); v += dpp_mov<0x140>(v);
    v += __shfl_xor(v, 16); v += __shfl_xor(v, 32);
    return v;
}
__device__ __forceinline__ void convpool_item(const Ctx& C, int l, int b, int pos0, int nvalid, LAS unsigned char* lds) {
    const int tid = pg8::opaque_tid(), lane = tid & 63, wid = __builtin_amdgcn_readfirstlane(tid >> 6), fr = lane & 15, fq = lane >> 4;
    const int cp = (wid & 1) * 64 + lane, tg = wid >> 1;
    const bf16* P = (const bf16*)C.out; bf16* Y = (bf16*)(C.ws + WS_Y);
    const bf16* sw = (const bf16*)(C.ws + WS_SMALLW + l * SMALLW_LAYER);
    const bool act = tg * 16 < nvalid;
    const int nrows = nvalid + 30;
    const int pg = wid & 3, pth = wid >> 2, pch = 64 * pg + lane;
    const bool pact = pth * 32 < nvalid;
    float xr[47];
    if (pact) {
#pragma unroll
        for (int i = 0; i < 47; ++i) { const int q = pos0 + pth * 32 - 15 + i; const unsigned v = *(const unsigned short*)(P + (size_t)row_of(b, max(q, 0)) * DIN + C_POOL + pch); xr[i] = q >= 0 ? __uint_as_float(v << 16) : 0.f; }
    }
#pragma unroll 1
    for (int pi = wid; pi < 127; pi += NWAVES) {
        const char* gp; int loff;
        if (pi < 96) { const int isg = pi >= 48, pr = (isg ? pi - 48 : pi) * 2 + (lane >> 5); const int q = pos0 - 30 + pr;
            gp = (const char*)(P + (size_t)row_of(b, max(q, 0)) * DIN + (isg ? C_BGATE : C_BVAL) + (lane & 31) * 8); loff = (isg ? L_G : L_V) + (pr & ~1) * 512; }
        else { const int k = pi - 96; gp = (const char*)(C.in[6] + ((size_t)l * CONVK + k) * DCONV + lane * 4); loff = L_W + k * 1024; }
        __builtin_amdgcn_global_load_lds((const unsigned*)gp, (LAS unsigned*)(lds + __builtin_amdgcn_readfirstlane(loff)), 16, 0, 0);
    }
    if (tid < 256) *(LAS float*)(lds + L_W + 31 * 1024 + tid * 4) = 0.f;
    const f32x2 bias = *(const f32x2*)(C.in[7] + l * DCONV + 2 * cp);
    const f32x2 lg = *(const f32x2*)(C.in[8] + l * DCONV + 2 * cp), lb = *(const f32x2*)(C.in[9] + l * DCONV + 2 * cp);
    asm volatile("s_waitcnt vmcnt(0)" ::: "memory");
    __syncthreads();
#pragma unroll 2
    for (int i = 0; i < 24; ++i) { const int r = tg + 4 * i; const int q = pos0 - 30 + r;
        const unsigned vv = *(const LAS unsigned*)(lds + L_V + r * 512 + cp * 4), gg = *(const LAS unsigned*)(lds + L_G + r * 512 + cp * 4);
        const bool ok = q >= 0 && r < nrows;
        *(LAS unsigned*)(lds + L_V + r * 512 + cp * 4) = ok ? pk_bf16(bf_lo(vv) * sigm(bf_lo(gg)), bf_hi(vv) * sigm(bf_hi(gg))) : 0u; }
    __syncthreads();
    if (pact) {
#define POOL_BODY(W) do { float sum = 0.f; \
        _Pragma("unroll") for (int d = 1; d < (W); ++d) sum += xr[15 - d]; \
        _Pragma("unroll") for (int j = 0; j < 32; ++j) { const int i = j + 15; sum += xr[i]; \
            const int q = pos0 + pth * 32 + j; const float inv = __builtin_amdgcn_rcpf((float)min(q + 1, (W))); const float o = sum * inv - xr[i]; \
            *(LAS unsigned short*)(lds + L_PA + (pth * 32 + j) * ASTRIDE + pch * 2) = (unsigned short)(pk_bf16(o, 0.f) & 0xffffu); \
            sum -= xr[i - (W) + 1]; } } while (0)
        if (pg == 0) POOL_BODY(2); else if (pg == 1) POOL_BODY(4); else if (pg == 2) POOL_BODY(8); else POOL_BODY(16);
#undef POOL_BODY
    }
    f32x2 acc[16];
    if (act) {
#pragma unroll
        for (int j = 0; j < 16; ++j) acc[j] = bias;
#pragma unroll 1
        for (int kc = 0; kc < 8; ++kc) {
            f32x2 w4[4], u[19];
#pragma unroll
            for (int t = 0; t < 4; ++t) w4[t] = *(const LAS f32x2*)(lds + L_W + (4 * kc + t) * 1024 + cp * 8);
#pragma unroll
            for (int i = 0; i < 19; ++i) { const unsigned uu = *(const LAS unsigned*)(lds + L_V + (tg * 16 + 4 * kc + i) * 512 + cp * 4); u[i] = (f32x2){bf_lo(uu), bf_hi(uu)}; }
#pragma unroll
            for (int j = 0; j < 16; ++j)
#pragma unroll
                for (int t = 0; t < 4; ++t) acc[j] += w4[t] * u[j + t];
        }
#pragma unroll
        for (int j = 0; j < 16; ++j) {
            const float s1 = wave_sum_fast(acc[j].x + acc[j].y), sq = wave_sum_fast(acc[j].x * acc[j].x + acc[j].y * acc[j].y);
            if (lane == 0) *(LAS f32x2*)(lds + L_STATS + ((tg * 16 + j) * 2 + (wid & 1)) * 8) = (f32x2){s1, sq};
        }
    }
    const int n0 = 32 * wid, g4 = wid >> 1, d0 = n0 & 63;
    const bf16* pwt = sw + SW_PW / 2; const bf16* plt = sw + SW_POOL / 2 + g4 * 4096;
    bf16x8 Bp[8][2], Bq[2][2];
#pragma unroll
    for (int kk = 0; kk < 8; ++kk)
#pragma unroll
        for (int n = 0; n < 2; ++n) Bp[kk][n] = *(const bf16x8*)(pwt + (size_t)(n0 + 16 * n + fr) * 256 + 32 * kk + 8 * fq);
#pragma unroll
    for (int kk = 0; kk < 2; ++kk)
#pragma unroll
        for (int n = 0; n < 2; ++n) Bq[kk][n] = *(const bf16x8*)(plt + (size_t)(d0 + 16 * n + fr) * 64 + 32 * kk + 8 * fq);
    __syncthreads();
    if (act) {
#pragma unroll
        for (int j = 0; j < 16; ++j) {
            const f32x4 st = *(LAS f32x4*)(lds + L_STATS + (tg * 16 + j) * 16);
            const float mean = (st.x + st.z) * (1.0f / DCONV), var = fmaxf((st.y + st.w) * (1.0f / DCONV) - mean * mean, 0.f), rstd = __builtin_amdgcn_rsqf(var + EPS);
            f32x2 y = (acc[j] - mean) * rstd * lg + lb;
            y.x = y.x * sigm(y.x); y.y = y.y * sigm(y.y);
            *(LAS unsigned*)(lds + L_CA + (tg * 16 + j) * ASTRIDE + cp * 4) = pk_bf16(y.x, y.y);
        }
    }
    __syncthreads();
    {
        pg8::f32x4 accb[4][2], acca[4][2];
#pragma unroll
        for (int m = 0; m < 4; ++m)
#pragma unroll
            for (int n = 0; n < 2; ++n) { accb[m][n] = (pg8::f32x4){0.f, 0.f, 0.f, 0.f}; acca[m][n] = (pg8::f32x4){0.f, 0.f, 0.f, 0.f}; }
#pragma unroll
        for (int kk = 0; kk < 8; ++kk) {
#pragma unroll
            for (int m = 0; m < 4; ++m) { if (16 * m >= nvalid) continue; const bf16x8 Af = *(const LAS bf16x8*)(lds + L_CA + (16 * m + fr) * ASTRIDE + (32 * kk + 8 * fq) * 2);
#pragma unroll
                for (int n = 0; n < 2; ++n) accb[m][n] = __builtin_amdgcn_mfma_f32_16x16x32_bf16(Bp[kk][n], Af, accb[m][n], 0, 0, 0); }
        }
#pragma unroll
        for (int kk = 0; kk < 2; ++kk) {
#pragma unroll
            for (int m = 0; m < 4; ++m) { if (16 * m >= nvalid) continue; const bf16x8 Af = *(const LAS bf16x8*)(lds + L_PA + (16 * m + fr) * ASTRIDE + (64 * g4 + 32 * kk + 8 * fq) * 2);
#pragma unroll
                for (int n = 0; n < 2; ++n) acca[m][n] = __builtin_amdgcn_mfma_f32_16x16x32_bf16(Bq[kk][n], Af, acca[m][n], 0, 0, 0); }
        }
        const float* psc = C.in[5] + l * DPOOL;
        f32x4 sc[2];
#pragma unroll
        for (int n = 0; n < 2; ++n) sc[n] = *(const f32x4*)(psc + n0 + 16 * n + 4 * fq);
#pragma unroll
        for (int m = 0; m < 4; ++m) { const int tok = 16 * m + fr;
            if (tok < nvalid) { bf16* yr = Y + (size_t)row_of(b, pos0 + tok) * D;
#pragma unroll
                for (int n = 0; n < 2; ++n) { const int col = n0 + 16 * n + 4 * fq;
                    const pg8::f32x4 a = acca[m][n], c = accb[m][n];
                    u32x2 wa; wa.x = pk_bf16(a[0] * sc[n].x, a[1] * sc[n].y); wa.y = pk_bf16(a[2] * sc[n].z, a[3] * sc[n].w);
                    u32x2 wb; wb.x = pk_bf16(c[0], c[1]); wb.y = pk_bf16(c[2], c[3]);
                    *(u32x2*)(yr + col) = wa; *(u32x2*)(yr + DPOOL + col) = wb; } } }
    }
    __syncthreads();
}

__device__ __forceinline__ void rg_item(const Ctx& C, int l, int b, int pos0, int nvalid, int hp, int tile, LAS unsigned char* lds) {
    const int tid = pg8::opaque_tid(), lane = tid & 63, wid = __builtin_amdgcn_readfirstlane(tid >> 6), fr = lane & 15, fq = lane >> 4;
    const int hsel = wid >> 2, nt = wid & 3, hh = 2 * hp + hsel, cb = 64 * hh, c0 = 16 * nt + 4 * fq, cl = hsel * 64 + c0;
    const bf16* P = (const bf16*)C.out; bf16* Y = (bf16*)(C.ws + WS_Y); bf16* GPb = (bf16*)(C.ws + WS_GP);
    const bf16* sw = (const bf16*)(C.ws + WS_SMALLW + l * SMALLW_LAYER);
    float* agg = (float*)(C.ws + WS_AGG) + (size_t)l * AG_LAYER;
    const int mcnt = (nvalid + 15) >> 4;
    {
        const int cg = tid & 15, tq = tid >> 4, cx = 128 * hp + 8 * cg;
        if (8 * tq < 16 * mcnt) {
            f32x4 wk[4][2];
#pragma unroll
            for (int k = 0; k < 4; ++k) { wk[k][0] = *(const f32x4*)(C.in[11] + (size_t)(l * 4 + k) * DRNN + cx); wk[k][1] = *(const f32x4*)(C.in[11] + (size_t)(l * 4 + k) * DRNN + cx + 4); }
            const f32x4 bs0 = *(const f32x4*)(C.in[12] + l * DRNN + cx), bs1 = *(const f32x4*)(C.in[12] + l * DRNN + cx + 4);
            u32x4 xr[11];
#pragma unroll
            for (int i = 0; i < 11; ++i) { const int q = pos0 + 8 * tq - 3 + i; const u32x4 raw = *(const u32x4*)(P + (size_t)row_of(b, max(q, 0)) * DIN + C_CX + cx); xr[i] = q >= 0 ? raw : (u32x4){0u, 0u, 0u, 0u}; }
#pragma unroll
            for (int t = 0; t < 8; ++t) {
                f32x4 a0 = bs0, a1 = bs1;
#pragma unroll
                for (int k = 0; k < 4; ++k) { const u32x4 raw = xr[t + k];
                    a0 += wk[k][0] * (f32x4){bf_lo(raw.x), bf_hi(raw.x), bf_lo(raw.y), bf_hi(raw.y)};
                    a1 += wk[k][1] * (f32x4){bf_lo(raw.z), bf_hi(raw.z), bf_lo(raw.w), bf_hi(raw.w)}; }
                u32x4 pk; pk.x = pk_bf16(a0.x, a0.y); pk.y = pk_bf16(a0.z, a0.w); pk.z = pk_bf16(a1.x, a1.y); pk.w = pk_bf16(a1.z, a1.w);
                *(LAS u32x4*)(lds + L_XC + (8 * tq + t) * XCSTRIDE + cg * 16) = pk;
            }
        }
    }
    const int cgl = DRNN * l + cb + c0;
    const f32x4 ba = *(const f32x4*)(C.in[14] + cgl), bx = *(const f32x4*)(C.in[16] + cgl), lam = *(const f32x4*)(C.in[17] + cgl);
    f32x4 sp;
#pragma unroll
    for (int v = 0; v < 4; ++v) sp[v] = 8.0f * log1pf(__expf(-lam[v]));
    bf16x8 Ba[2], Bx[2];
#pragma unroll
    for (int kk = 0; kk < 2; ++kk) { const size_t o = (size_t)(hh * 64 + 16 * nt + fr) * 64 + 32 * kk + 8 * fq; Ba[kk] = *(const bf16x8*)(sw + SW_WA / 2 + o); Bx[kk] = *(const bf16x8*)(sw + SW_WX / 2 + o); }
    u32x2 gnext = *(const u32x2*)(P + (size_t)row_of(b, pos0 + fr) * DIN + C_CGATE + cb + c0);
    __syncthreads();
    f32x4 cP = (f32x4){1.f, 1.f, 1.f, 1.f}, cH = (f32x4){0.f, 0.f, 0.f, 0.f};
    const int bsrc = (lane & 48) | 15;
#pragma unroll 1
    for (int m = 0; m < mcnt; ++m) {
        const int tok = 16 * m + fr; const bool valid = tok < nvalid;
        const size_t row = (size_t)row_of(b, pos0 + tok);
        const u32x2 graw = gnext;
        if (m + 1 < mcnt) gnext = *(const u32x2*)(P + (size_t)row_of(b, pos0 + tok + 16) * DIN + C_CGATE + cb + c0);
        pg8::f32x4 ga = (pg8::f32x4){0.f, 0.f, 0.f, 0.f}, gx = (pg8::f32x4){0.f, 0.f, 0.f, 0.f};
#pragma unroll
        for (int kk = 0; kk < 2; ++kk) { const bf16x8 Af = *(const LAS bf16x8*)(lds + L_XC + tok * XCSTRIDE + (hsel * 64 + 32 * kk + 8 * fq) * 2);
            ga = __builtin_amdgcn_mfma_f32_16x16x32_bf16(Ba[kk], Af, ga, 0, 0, 0); gx = __builtin_amdgcn_mfma_f32_16x16x32_bf16(Bx[kk], Af, gx, 0, 0, 0); }
        const u32x2 xraw = *(const LAS u32x2*)(lds + L_XC + tok * XCSTRIDE + cl * 2);
        const f32x4 xc = (f32x4){bf_lo(xraw.x), bf_hi(xraw.x), bf_lo(xraw.y), bf_hi(xraw.y)};
        const f32x4 gt = (f32x4){bf_lo(graw.x), bf_hi(graw.x), bf_lo(graw.y), bf_hi(graw.y)};
        f32x4 Pt, Ht;
#pragma unroll
        for (int v = 0; v < 4; ++v) {
            const float r = sigm(ga[v] + ba[v]), ig = sigm(gx[v] + bx[v]);
            float a = __expf(-r * sp[v]);
            float bb = __builtin_amdgcn_sqrtf(fmaxf(1.0f - a * a, 0.f)) * ig * xc[v];
            if (!valid) { a = 1.0f; bb = 0.0f; }
            { float ap = dpp_shr<1>(1.0f, a), bp = dpp_shr<1>(0.0f, bb); bb = bb + a * bp; a = a * ap; }
            { float ap = dpp_shr<2>(1.0f, a), bp = dpp_shr<2>(0.0f, bb); bb = bb + a * bp; a = a * ap; }
            { float ap = dpp_shr<4>(1.0f, a), bp = dpp_shr<4>(0.0f, bb); bb = bb + a * bp; a = a * ap; }
            { float ap = dpp_shr<8>(1.0f, a), bp = dpp_shr<8>(0.0f, bb); bb = bb + a * bp; a = a * ap; }
            Pt[v] = a * cP[v]; Ht[v] = bb + a * cH[v];
        }
        if (valid) {
            f32x4 G;
#pragma unroll
            for (int v = 0; v < 4; ++v) G[v] = gelu_tanh(gt[v]);
            u32x2 w1; w1.x = pk_bf16(G[0] * Ht[0], G[1] * Ht[1]); w1.y = pk_bf16(G[2] * Ht[2], G[3] * Ht[3]);
            u32x2 w2; w2.x = pk_bf16(G[0] * Pt[0], G[1] * Pt[1]); w2.y = pk_bf16(G[2] * Pt[2], G[3] * Pt[3]);
            *(u32x2*)(Y + row * D + 512 + cb + c0) = w1; if (tile >= 0) *(u32x2*)(GPb + row * DRNN + cb + c0) = w2;
        }
#pragma unroll
        for (int v = 0; v < 4; ++v) { cP[v] = __shfl(Pt[v], bsrc); cH[v] = __shfl(Ht[v], bsrc); }
    }
    if (fr == 0) {
        if (tile >= 0) { const size_t o = ((size_t)b * 32 + tile) * 512 + cb + c0; *(f32x4*)(agg + AG_TP + o) = cP; *(f32x4*)(agg + AG_TH + o) = cH; }
        else { *(f32x4*)(agg + AG_MP + cb + c0) = cP; *(f32x4*)(agg + AG_MH + cb + c0) = cH; }
    }
    __syncthreads();
}

__device__ __forceinline__ void rg_fix_item(const Ctx& C, int l, int b, int tile, int hp, bf16* Yout) {
    const int tid = pg8::opaque_tid(), lane = tid & 63, wid = __builtin_amdgcn_readfirstlane(tid >> 6);
    const int hsel = wid & 1, s = wid >> 1, c = 64 * (2 * hp + hsel) + 8 * (lane & 7), r8 = lane >> 3;
    const bf16* Y = (const bf16*)(C.ws + WS_Y); const bf16* GPb = (const bf16*)(C.ws + WS_GP); const float* agg = (const float*)(C.ws + WS_AGG) + (size_t)l * AG_LAYER;
    f32x4 H0 = *(const f32x4*)(agg + AG_MH + c), H1 = *(const f32x4*)(agg + AG_MH + c + 4);
#pragma unroll 8
    for (int jj = 0; jj < tile; ++jj) { const size_t o = ((size_t)b * 32 + jj) * 512 + c;
        const f32x4 p0 = *(const f32x4*)(agg + AG_TP + o), p1 = *(const f32x4*)(agg + AG_TP + o + 4), h0 = *(const f32x4*)(agg + AG_TH + o), h1 = *(const f32x4*)(agg + AG_TH + o + 4);
        H0 = h0 + p0 * H0; H1 = h1 + p1 * H1; }
#pragma unroll 8
    for (int it = 0; it < 8; ++it) {
        const size_t row = (size_t)b * SEQ + tile * 256 + 64 * s + 8 * it + r8;
        const u32x4 gh = *(const u32x4*)(Y + row * D + 512 + c), gp = *(const u32x4*)(GPb + row * DRNN + c);
        u32x4 o;
        o.x = pk_bf16(bf_lo(gh.x) + bf_lo(gp.x) * H0.x, bf_hi(gh.x) + bf_hi(gp.x) * H0.y);
        o.y = pk_bf16(bf_lo(gh.y) + bf_lo(gp.y) * H0.z, bf_hi(gh.y) + bf_hi(gp.y) * H0.w);
        o.z = pk_bf16(bf_lo(gh.z) + bf_lo(gp.z) * H1.x, bf_hi(gh.z) + bf_hi(gp.z) * H1.y);
        o.w = pk_bf16(bf_lo(gh.w) + bf_lo(gp.w) * H1.z, bf_hi(gh.w) + bf_hi(gp.w) * H1.w);
        st16_wt(Yout + row * D + 512 + c, o);
    }
}

__device__ __forceinline__ void final_norm(const Ctx& C) {
    const int tid = pg8::opaque_tid(), lane = tid & 63, wave = tid >> 6;
    const int gw = blockIdx.x * NWAVES + wave, NGW = gridDim.x * NWAVES;
    const float* part = (const float*)(C.ws + WS_PART);
    f32x4 g[4];
#pragma unroll
    for (int j = 0; j < 4; ++j) g[j] = ((const f32x4*)C.in[22])[lane + 64 * j];
    for (int m0 = gw; m0 < MMAIN; m0 += 4 * NGW) {
        f32x4 s4[4]; u32x2 h[4][4];
#pragma unroll
        for (int u = 0; u < 4; ++u) { const int m = min(m0 + u * NGW, MMAIN - 1); const f32x4* pp = (const f32x4*)(part + (size_t)m * 16); s4[u] = (pp[0] + pp[1]) + (pp[2] + pp[3]);
            const u32x2* hr = (const u32x2*)((const bf16*)(C.ws + WS_HB) + (size_t)m * D);
#pragma unroll
            for (int j = 0; j < 4; ++j) h[u][j] = hr[lane + 64 * j]; }
#pragma unroll
        for (int u = 0; u < 4; ++u) { const int m = m0 + u * NGW; if (m < MMAIN) {
            const float rs = __builtin_amdgcn_rsqf(((s4[u].x + s4[u].y) + (s4[u].z + s4[u].w)) * (1.0f / D) + EPS);
            f32x4* o = (f32x4*)(C.out + (size_t)m * D);
#ifdef PROBE_TW
            const float dlt = ((const float*)(C.ws + WS_CTL + 65536))[0];
#else
            const float dlt = 0.f;
#endif
#pragma unroll
            for (int j = 0; j < 4; ++j) o[lane + 64 * j] = (f32x4){bf_lo(h[u][j].x), bf_hi(h[u][j].x), bf_lo(h[u][j].y), bf_hi(h[u][j].y)} * rs * g[j] + dlt; } }
    }
}

#define XB_TMO      128
#define XB_XCNT(j)  (256  + 64 * (j))
#define XB_XSUB(j)  (1280 + 64 * (j))
#define XB_XGEN(j)  (2304 + 64 * (j))
#define XB_TOP      3328
#define XB_TOPGEN   3392
#define XCD_BAR_WORDS 3456
#define XB_SPIN_CAP (1u << 18)

__device__ __forceinline__ unsigned xb_ld(unsigned* p)              { return __hip_atomic_load(p, __ATOMIC_RELAXED, __HIP_MEMORY_SCOPE_AGENT); }
__device__ __forceinline__ unsigned xb_add(unsigned* p, unsigned v) { return __hip_atomic_fetch_add(p, v, __ATOMIC_RELAXED, __HIP_MEMORY_SCOPE_AGENT); }
__device__ __forceinline__ unsigned xb_xcc_id() { return (unsigned)__builtin_amdgcn_s_getreg((3 << 11) | 20) & 0xFu; }
#define XB_SPIN(cond, bar) do { unsigned _sp = 0; while (cond) { __builtin_amdgcn_s_sleep(1); \
    if ((++_sp & 255u) == 0u) { if (xb_ld(&(bar)[XB_TMO])) break; if (_sp > XB_SPIN_CAP) { atomicAdd(&(bar)[XB_TMO], 1u); break; } } } } while (0)

struct XcdBarrier {
    unsigned* bar; unsigned x;
    volatile LAS unsigned* st;
};

__device__ __forceinline__ XcdBarrier xcd_barrier_post(unsigned* bar, volatile LAS unsigned* st) {
    XcdBarrier b; b.bar = bar; b.x = xb_xcc_id(); b.st = st;
    if (threadIdx.x == 0) (void)xb_add(&bar[XB_XCNT(b.x)], 1u);
    return b;
}
__device__ __forceinline__ void xcd_barrier_complete(unsigned* bar, unsigned x, unsigned& nloc, unsigned& nx) {
    const unsigned G = gridDim.x * gridDim.y * gridDim.z;
    unsigned sum, cnt, mine, sp = 0u;
    for (;;) {
        sum = 0u; cnt = 0u; mine = 0u;
#pragma unroll
        for (unsigned j = 0; j < 16; ++j) { const unsigned c = xb_ld(&bar[XB_XCNT(j)]); sum += c; cnt += (c > 0u) ? 1u : 0u; mine = (j == x) ? c : mine; }
        if (sum == G) break;
        __builtin_amdgcn_s_sleep(1);
        if ((++sp & 255u) == 0u) { if (xb_ld(&bar[XB_TMO])) break; if (sp > XB_SPIN_CAP) { atomicAdd(&bar[XB_TMO], 1u); break; } }
    }
    nloc = mine > 0u ? mine : 1u; nx = cnt > 0u ? cnt : 1u;
}

__device__ __forceinline__ void xcd_barrier(const XcdBarrier& b) {
    asm volatile("s_waitcnt vmcnt(0)" ::: "memory");
    __syncthreads();
    if (threadIdx.x == 0) {
        unsigned* bar = b.bar;
        __builtin_amdgcn_s_waitcnt(0);
        unsigned nloc = b.st[0], nx = b.st[1];
        if (nloc == 0u) { xcd_barrier_complete(bar, b.x, nloc, nx); b.st[0] = nloc; b.st[1] = nx; }
        const unsigned old = xb_add(&bar[XB_XSUB(b.x)], 1u);
        const unsigned gen = old / nloc;
        if (old + 1u == (gen + 1u) * nloc) {
            __builtin_amdgcn_fence(__ATOMIC_RELEASE, "agent");
            asm volatile("s_waitcnt vmcnt(0)" ::: "memory");
            const unsigned og = xb_add(&bar[XB_TOP], 1u);
            const unsigned tg = og / nx;
            if (og + 1u == (tg + 1u) * nx) xb_add(&bar[XB_TOPGEN], 1u);
            else XB_SPIN(xb_ld(&bar[XB_TOPGEN]) == tg, bar);
            __builtin_amdgcn_fence(__ATOMIC_ACQUIRE, "agent");
            xb_add(&bar[XB_XGEN(b.x)], 1u);
            asm volatile("s_waitcnt vmcnt(0)" ::: "memory");
        } else {
            XB_SPIN(xb_ld(&bar[XB_XGEN(b.x)]) == gen, bar);
            __builtin_amdgcn_fence(__ATOMIC_ACQUIRE, "agent");
            asm volatile("s_waitcnt vmcnt(0)" ::: "memory");
        }
    }
    __syncthreads();
}

__device__ __forceinline__ void seam_signal(unsigned* cnt) {
    asm volatile("s_waitcnt vmcnt(0)" ::: "memory");
    __syncthreads();
    if (threadIdx.x == 0) { __builtin_amdgcn_fence(__ATOMIC_RELEASE, "agent"); asm volatile("s_waitcnt vmcnt(0)" ::: "memory"); __hip_atomic_fetch_add(cnt, 1u, __ATOMIC_RELAXED, __HIP_MEMORY_SCOPE_AGENT); }
}
__device__ __forceinline__ void seam_wait(unsigned* cnt, unsigned need) {
    if (threadIdx.x == 0) {
        unsigned sp = 0;
        while (__hip_atomic_load(cnt, __ATOMIC_RELAXED, __HIP_MEMORY_SCOPE_AGENT) < need) { __builtin_amdgcn_s_sleep(2); if (++sp > (1u << 20)) break; }
        __builtin_amdgcn_fence(__ATOMIC_ACQUIRE, "agent");
        asm volatile("s_waitcnt vmcnt(0)" ::: "memory");
    }
    __syncthreads();
}
__device__ __forceinline__ void final_norm_panel(const Ctx& C, int row0) {
    const int tid = pg8::opaque_tid(), lane = tid & 63, wave = tid >> 6;
    const float* part = (const float*)(C.ws + WS_PART);
    f32x4 g[4];
#pragma unroll
    for (int j = 0; j < 4; ++j) g[j] = ((const f32x4*)C.in[22])[lane + 64 * j];
#pragma unroll 1
    for (int i = 0; i < 2; ++i) {
        f32x4 s4[4]; u32x2 h[4][4];
#pragma unroll
        for (int u = 0; u < 4; ++u) { const int m = row0 + wave * 8 + i * 4 + u; const f32x4* pp = (const f32x4*)(part + (size_t)m * 16); s4[u] = (pp[0] + pp[1]) + (pp[2] + pp[3]);
            const u32x2* hr = (const u32x2*)((const bf16*)(C.ws + WS_HB) + (size_t)m * D);
#pragma unroll
            for (int j = 0; j < 4; ++j) h[u][j] = hr[lane + 64 * j]; }
#pragma unroll
        for (int u = 0; u < 4; ++u) { const int m = row0 + wave * 8 + i * 4 + u;
            const float rs = __builtin_amdgcn_rsqf(((s4[u].x + s4[u].y) + (s4[u].z + s4[u].w)) * (1.0f / D) + EPS);
            f32x4* o = (f32x4*)(C.out + (size_t)m * D);
#pragma unroll
            for (int j = 0; j < 4; ++j) o[lane + 64 * j] = (f32x4){bf_lo(h[u][j].x), bf_hi(h[u][j].x), bf_lo(h[u][j].y), bf_hi(h[u][j].y)} * rs * g[j]; }
    }
}

constexpr int N_PHASES = 2 + 6 * NLAYER;
struct Args { const float* in[23]; float* out; unsigned char* ws; int ph_lo, ph_hi; };
#ifndef PROBE_REP
#define PROBE_REP 0
#endif
__global__ void __launch_bounds__(NTHR) hymba_fwd(Args args) {
    extern __shared__ __attribute__((aligned(16))) unsigned char lds_raw[];
    LAS unsigned char* lds = (LAS unsigned char*)lds_raw;
    cg::grid_group grid = cg::this_grid();
    if (args.ph_hi < 0) grid.sync();
    { volatile LAS unsigned* st0 = (volatile LAS unsigned*)(lds + L_BARST); if (threadIdx.x < 16) st0[threadIdx.x] = 0u; }
    __syncthreads();
    XcdBarrier xbar = xcd_barrier_post((unsigned*)(args.ws + WS_CTL), (volatile LAS unsigned*)(lds + L_BARST));
    Ctx C;
#pragma unroll
    for (int i = 0; i < 23; ++i) C.in[i] = args.in[i];
    C.out = args.out; C.ws = args.ws;
    unsigned char* ws = args.ws;
    const int G = gridDim.x, bx = blockIdx.x;
    const bool grp = (G == 256);
    const int pmc = 8 * (bx % 8) + (bx / 8) % 8, kc = bx / 64;
    bf16* hb = (bf16*)(ws + WS_HB); float* part = (float*)(ws + WS_PART);
    for (int ph = args.ph_lo; ph < args.ph_hi; ++ph) {
        const bool fin = (ph == N_PHASES - 1);
        const int l = fin ? NLAYER - 1 : (ph - 1) / 6, k = fin ? 6 : (ph - 1) % 6;
        if (ph > args.ph_lo) {
            if (!grp || ph == 1 || k == 1 || k == 2) xcd_barrier(xbar);
            else if (k == 0) seam_wait(seam_cnt(ws, l - 1, 3, pmc), 4u);
            else if (k == 3) seam_wait(seam_cnt(ws, l, 0, pmc), 4u);
            else if (k == 4) seam_wait(seam_cnt(ws, l, 1, pmc), 4u);
            else if (k == 5) seam_wait(seam_cnt(ws, l, 2, pmc), 4u);
            else seam_wait(seam_cnt(ws, l, 3, pmc), 4u);
        }
        const int nrep = 1 + ((PROBE_REP >> (ph == 0 ? 0 : k + 1)) & 1);
        for (int rep = 0; rep < nrep; ++rep) {
#if defined(PROBE_ACQREP)
        if (rep > 0) { if (threadIdx.x == 0) { __builtin_amdgcn_fence(__ATOMIC_ACQUIRE, "agent"); asm volatile("s_waitcnt vmcnt(0)" ::: "memory"); } __syncthreads(); }
#elif defined(PROBE_RELREP)
        if (rep > 0) { if (threadIdx.x == 0) { __builtin_amdgcn_fence(__ATOMIC_RELEASE, "agent"); asm volatile("s_waitcnt vmcnt(0)" ::: "memory"); } __syncthreads(); }
#elif defined(PROBE_BARREP)
        if (rep > 0) xcd_barrier(xbar);
#endif
        if (ph == 0) { p0_prologue(C, lds, 0, grp ? 1 : NLAYER, 1, bx, G); continue; }
        if (fin) { if (grp) final_norm_panel(C, 256 * pmc + 64 * kc); else final_norm(C); continue; }
        if (k == 0) {
            const bf16* Wt = (const bf16*)(ws + WS_WIN) + (size_t)l * D * DIN;
            pg8::Gemm g{hb, Wt, MMAIN, DIN, D}; pg8::StaticOrder S; S.init(MMAIN, DIN, G, bx);
            EpiScale<false> E{(bf16*)C.out, DIN, part};
            pg8::gemm_phase<EpiScale<false>, pg8::StaticOrder, true, true>(lds, g, S, E);
            for (int t = G - 1 - bx; t < DIN / 64; t += G) {
                if (grp && l > 0) seam_wait(meta_cnt(ws, l - 1, 2), D / 64);
                skinny_task<0>(hb + (size_t)MMAIN * D, Wt, D, t, (bf16*)C.out, DIN, part, lds);
                if (grp) seam_signal(meta_cnt(ws, l, 3)); }
            if (grp && bx >= 192) {
                if (bx < 197) { seam_wait(meta_cnt(ws, l, 3), DIN / 64);
                    if (bx < 196) rg_item(C, l, 0, 0, NMETA, bx - 192, -1, lds); else convpool_item(C, l, 0, 0, NMETA, lds); }
                if (l + 1 < NLAYER && bx >= 197) p0_prologue(C, lds, l + 1, l + 2, 0, bx - 197, 59);
            }
        } else if (k == 1) {
            for (int r2 = 0; r2 <= ((PROBE_REP >> 8) & 1); ++r2)
            for (int it = bx; it < (grp ? 256 : 257); it += G) {
                if (it < 256) convpool_item(C, l, it >> 7, NMETA + 64 * (it & 127), 64, lds);
                else convpool_item(C, l, 0, 0, NMETA, lds);
            }
            for (int r2 = 0; r2 <= ((PROBE_REP >> 9) & 1); ++r2)
            for (int it = bx; it < (grp ? 256 : 260); it += G) {
                if (it < 256) rg_item(C, l, it >> 7, NMETA + 256 * ((it >> 2) & 31), 256, it & 3, (it >> 2) & 31, lds);
                else rg_item(C, l, 0, 0, NMETA, it - 256, -1, lds);
            }
        } else if (k == 2) {
            for (int it = bx; it < 256; it += G) { rg_fix_item(C, l, it >> 7, (it >> 2) & 31, it & 3, (bf16*)(ws + WS_Y)); if (grp) seam_signal(seam_cnt(ws, l, 0, it >> 2)); }
        } else if (k == 3) {
            const bf16* Wt = (const bf16*)(ws + WS_WOUT) + (size_t)l * D * D;
            pg8::Gemm g{(const bf16*)(ws + WS_Y), Wt, MMAIN, D, D}; pg8::StaticOrder S; S.init(MMAIN, D, G, bx);
            EpiResid E{hb, hb, part};
            pg8::gemm_phase<EpiResid, pg8::StaticOrder, true, true>(lds, g, S, E);
            if (grp) seam_signal(seam_cnt(ws, l, 1, pmc));
            if (l + 1 < NLAYER) for (int t = bx; t < D / 64; t += G) {
                skinny_task<2>((const bf16*)(ws + WS_Y) + (size_t)MMAIN * D, Wt, D, t, hb, D, part, lds);
                if (grp) seam_signal(meta_cnt(ws, l, 0)); }
        } else if (k == 4) {
            const bf16* Wt = (const bf16*)(ws + WS_WUP) + (size_t)l * D * DFF;
            pg8::Gemm g{hb, Wt, MMAIN, DFF, D}; pg8::StaticOrder S; S.init(MMAIN, DFF, G, bx);
            EpiScale<true> E{(bf16*)(ws + WS_HID), DFF, part};
            pg8::gemm_phase<EpiScale<true>, pg8::StaticOrder, true, true>(lds, g, S, E);
            if (grp && rep == nrep - 1) seam_signal(seam_cnt(ws, l, 2, pmc));
            if (l + 1 < NLAYER && rep == 0) for (int t = bx; t < DFF / 64; t += G) {
                if (grp) seam_wait(meta_cnt(ws, l, 0), D / 64);
                skinny_task<1>(hb + (size_t)MMAIN * D, Wt, D, t, (bf16*)(ws + WS_HID), DFF, part, lds);
                if (grp) seam_signal(meta_cnt(ws, l, 1)); }
        } else {
            const bf16* Wt = (const bf16*)(ws + WS_WDN) + (size_t)l * DFF * D;
            pg8::Gemm g{(const bf16*)(ws + WS_HID), Wt, MMAIN, D, DFF}; pg8::StaticOrder S; S.init(MMAIN, D, G, bx);
            EpiResid E{hb, hb, part};
            pg8::gemm_phase<EpiResid, pg8::StaticOrder, true, true>(lds, g, S, E);
            if (grp) seam_signal(seam_cnt(ws, l, 3, pmc));
            if (l + 1 < NLAYER) for (int t = bx - 16; t >= 0 && t < D / 64; t += G) {
                if (grp) seam_wait(meta_cnt(ws, l, 1), DFF / 64);
                skinny_task<2>((const bf16*)(ws + WS_HID) + (size_t)MMAIN * DFF, Wt, DFF, t, hb, D, part, lds);
                if (grp) seam_signal(meta_cnt(ws, l, 2)); }
        }
        }
    }
}

extern "C" void kernel_launch(void* const* d_in, const int* in_sizes, int n_in, void* d_out, int out_size, void* d_ws, size_t ws_size, hipStream_t stream) {
    static int grid = 0;
    if (grid == 0) {
        if (n_in != 23 || out_size != MMAIN * D || ws_size < WS_END) { fprintf(stderr, "kernel_launch: unexpected shapes (n_in %d out %d ws %zu)\n", n_in, out_size, ws_size); grid = -1; return; }
        int dev = 0, cus = 0, per_cu = 0;
        hipGetDevice(&dev); hipDeviceGetAttribute(&cus, hipDeviceAttributeMultiprocessorCount, dev);
        hipFuncSetAttribute((const void*)hymba_fwd, hipFuncAttributeMaxDynamicSharedMemorySize, LDS_BYTES);
        hipOccupancyMaxActiveBlocksPerMultiprocessor(&per_cu, (const void*)hymba_fwd, NTHR, LDS_BYTES);
        if (per_cu < 1) per_cu = 1;
        (void)hipGetLastError();
        grid = cus;
    }
    if (grid < 0) return;
    if (hipMemsetAsync((char*)d_ws + WS_CTL, 0, CTL_ZERO_BYTES, stream) != hipSuccess) { fprintf(stderr, "kernel_launch: memset failed\n"); return; }
    Args a{};
    for (int i = 0; i < 23; ++i) a.in[i] = (const float*)d_in[i];
    a.out = (float*)d_out; a.ws = (unsigned char*)d_ws; a.ph_lo = 0; a.ph_hi = N_PHASES;
    void* kargs[] = {&a};
    hipError_t e = hipLaunchCooperativeKernel((const void*)hymba_fwd, dim3(grid), dim3(NTHR), kargs, LDS_BYTES, stream);
    if (e != hipSuccess) fprintf(stderr, "kernel_launch: cooperative launch failed: %s (grid %d)\n", hipGetErrorString(e), grid);
}
```

```cpp
#include <hip/hip_runtime.h>
#include <hip/hip_cooperative_groups.h>
#include <cstdio>
#include <cstdint>
namespace cg = cooperative_groups;
namespace pg8 {
#define PG8_LAS __attribute__((address_space(3)))
typedef unsigned short bf16_t;
typedef short bf16x8 __attribute__((ext_vector_type(8)));
typedef float f32x4 __attribute__((ext_vector_type(4)));
typedef unsigned u32x4 __attribute__((ext_vector_type(4)));
constexpr int BM = 256, BK = 64, HALF = 128, HTB = HALF * BK * 2  , STAGE_BYTES = 8 * HTB, NXCD = 8, WGM = 8;

__host__ __device__ __forceinline__ int lds_byte(int r, int c) { const int st = (r >> 4) * 2 + (c >> 5), rr = r & 15, cc = c & 31, ob = rr * 64 + cc * 2; return st * 1024 + (ob ^ (((ob >> 9) & 1) << 5)); }
__host__ __device__ __forceinline__ void stage_rc(int b, int& R, int& C) { const int st = b / 1024, sb = b % 1024, swz = sb ^ (((sb >> 9) & 1) << 5); R = (st >> 1) * 16 + swz / 64; C = (st & 1) * 32 + (swz % 64) / 2; }
__host__ __device__ __forceinline__ int perm32(int rho) { const int n = rho >> 4, i = rho & 15; return 8 * (i >> 2) + 4 * n + (i & 3); }

__device__ __forceinline__ int opaque_tid() { int t = threadIdx.x; asm volatile("" : "+v"(t)); return t; }
struct Unit { int pm, pn; };
struct Gemm { const bf16_t* A; const bf16_t* Bt; int M, N, K; };

struct StaticOrder {
    int nM, nN, nwg, G, c;
    __host__ __device__ void init(int M, int N, int G_, int c_) { nM = M / BM; nN = N / BM; nwg = nM * nN; G = G_; c = c_; }
    __host__ __device__ bool next(int i, Unit& u) const {
        const long L = (long)i * G + c; if (L >= nwg) return false;
        int wgid = (int)L; { const int q = nwg / NXCD, r = nwg % NXCD, xcd = wgid % NXCD, off = wgid / NXCD; wgid = (xcd < r ? xcd * (q + 1) : r * (q + 1) + (xcd - r) * q) + off; }
        const int nig = WGM * nN, gid = wgid / nig, fm = gid * WGM, gsz = (nM - fm) < WGM ? (nM - fm) : WGM;
        u.pm = fm + ((wgid % nig) % gsz); u.pn = (wgid % nig) / gsz; return true;
    }
    __device__ __forceinline__ void a_ready(const Unit&) const {}
    __device__ __forceinline__ void done(const Unit&) const {}
};
__device__ __forceinline__ unsigned cvt_pk_bf16(float lo, float hi) { unsigned r; asm volatile("v_cvt_pk_bf16_f32 %0, %1, %2" : "=v"(r) : "v"(lo), "v"(hi)); return r; }
template <class Epi, class Sched, bool ALIGN_EPI = false, bool SP2 = false>
__device__ __forceinline__ void gemm_phase(PG8_LAS unsigned char* lds, const Gemm g, const Sched& S, const Epi& E) {
    const int tid = opaque_tid(), wid = __builtin_amdgcn_readfirstlane(tid >> 6), lane = tid & 63, wr = wid >> 2, wc = wid & 3, fr = lane & 15, fq = lane >> 4;
    const int K = g.K, nt = K / BK;
    unsigned voffA[2], voffB[2];
#pragma unroll
    for (int i = 0; i < 2; ++i) { int R, C; stage_rc(tid * 16 + i * 8192, R, C); const int Rb = Epi::PERM ? ((R & ~31) + perm32(R & 31)) : R;
        voffA[i] = (unsigned)(R * K + C) * 2u; voffB[i] = (unsigned)(Rb * K + C) * 2u; }
    const size_t kstep = (size_t)(BK * 2);
    const size_t hstep = (size_t)HALF * K * 2;
    const size_t tstep = 2 * hstep;
    const unsigned ldsw = (unsigned)wid * 1024u;
    const int aoff = lds_byte(wr * 64 + fr, fq * 8), boff = lds_byte(wc * 32 + fr, fq * 8);
#define PG8_SA(b, h) (((b) * 2 + (h)) * HTB)
#define PG8_SB(b, h) ((4 + (b) * 2 + (h)) * HTB)
#define PG8_STAGE(bufoff, gbase, voff) do { _Pragma("unroll") for (int _i = 0; _i < 2; ++_i) \
        __builtin_amdgcn_global_load_lds((const unsigned*)((const char*)(gbase) + (voff)[_i]), (PG8_LAS unsigned*)(lds + (bufoff) + ldsw + _i * 8192), 16, 0, 0); } while (0)
#define PG8_LDA(dst, b, h) do { _Pragma("unroll") for (int m = 0; m < 4; ++m) _Pragma("unroll") for (int k = 0; k < 2; ++k) dst[m][k] = *(const PG8_LAS bf16x8*)(lds + PG8_SA(b, h) + aoff + m * 2048 + k * 1024); } while (0)
#define PG8_LDB(dst, b, h) do { _Pragma("unroll") for (int n = 0; n < 2; ++n) _Pragma("unroll") for (int k = 0; k < 2; ++k) dst[n][k] = *(const PG8_LAS bf16x8*)(lds + PG8_SB(b, h) + boff + n * 2048 + k * 1024); } while (0)
#define PG8_MMA(ai, bj, At, Bt) do { __builtin_amdgcn_s_setprio(1); _Pragma("unroll") for (int m = 0; m < 4; ++m) _Pragma("unroll") for (int n = 0; n < 2; ++n) _Pragma("unroll") for (int k = 0; k < 2; ++k) \
        acc[ai][bj][m][n] = __builtin_amdgcn_mfma_f32_16x16x32_bf16(Bt[n][k], At[m][k], acc[ai][bj][m][n], 0, 0, 0); __builtin_amdgcn_s_setprio(0); } while (0)
#define PG8_WAIT_V(n) asm volatile("s_waitcnt vmcnt(" #n ")" ::: "memory")
#define PG8_WAIT_L(n) asm volatile("s_waitcnt lgkmcnt(" #n ")" ::: "memory")
#define PG8_BAR __builtin_amdgcn_s_barrier()
#define PG8_SCHED __builtin_amdgcn_sched_barrier(0)
    Unit cur, nxt; int ui = 0;
    if (!S.next(0, cur)) return;
    f32x4 acc[2][2][4][2];
#pragma unroll
    for (int a = 0; a < 2; ++a)
#pragma unroll
        for (int b = 0; b < 2; ++b)
#pragma unroll
            for (int m = 0; m < 4; ++m)
#pragma unroll
                for (int n = 0; n < 2; ++n) acc[a][b][m][n] = (f32x4){0.f, 0.f, 0.f, 0.f};
    bf16x8 At[4][2], B0[2][2], B1[2][2];
    const char* cA = (const char*)g.A + (size_t)cur.pm * tstep; const char* cB = (const char*)g.Bt + (size_t)cur.pn * tstep;
    S.a_ready(cur);
    if constexpr (SP2) {
        PG8_STAGE(PG8_SB(0, 0), cB, voffB); PG8_STAGE(PG8_SB(0, 1), cB + hstep, voffB); PG8_STAGE(PG8_SA(0, 0), cA, voffA); PG8_STAGE(PG8_SA(0, 1), cA + hstep, voffA);
        if (wr == 1) PG8_BAR;
        PG8_WAIT_V(2); PG8_BAR;
        PG8_STAGE(PG8_SB(1, 0), cB + kstep, voffB); PG8_STAGE(PG8_SA(1, 0), cA + kstep, voffA); PG8_STAGE(PG8_SB(1, 1), cB + hstep + kstep, voffB);
        PG8_WAIT_V(6); PG8_BAR;
    } else {
        PG8_STAGE(PG8_SB(0, 0), cB, voffB); PG8_STAGE(PG8_SA(0, 0), cA, voffA); PG8_STAGE(PG8_SB(0, 1), cB + hstep, voffB); PG8_STAGE(PG8_SA(0, 1), cA + hstep, voffA);
        if (wr == 1) PG8_BAR;
        PG8_WAIT_V(4); PG8_BAR;
        PG8_STAGE(PG8_SB(1, 0), cB + kstep, voffB); PG8_STAGE(PG8_SA(1, 0), cA + kstep, voffA); PG8_STAGE(PG8_SB(1, 1), cB + hstep + kstep, voffB);
        PG8_WAIT_V(6); PG8_BAR;
    }
    for (;;) {
        const bool has_next = S.next(ui + 1, nxt);
        const char* nA = has_next ? (const char*)g.A + (size_t)nxt.pm * tstep : cA; const char* nB = has_next ? (const char*)g.Bt + (size_t)nxt.pn * tstep : cB;
        for (int t = 0; t < nt; t += 2) {
            const bool last = (t == nt - 2);
            const char* a1 = cA + (size_t)(t + 1) * kstep;
            const char* a2 = last ? nA : cA + (size_t)(t + 2) * kstep; const char* b2 = last ? nB : cB + (size_t)(t + 2) * kstep;
            const char* a3 = a2 + kstep; const char* b3 = b2 + kstep;
            if (last && has_next) S.a_ready(nxt);
            if constexpr (SP2) {
            PG8_LDB(B0, 0, 0); PG8_LDB(B1, 0, 1); PG8_SCHED; PG8_LDA(At, 0, 0); PG8_STAGE(PG8_SA(1, 1), a1 + hstep, voffA);
            PG8_WAIT_V(8); PG8_WAIT_L(0); PG8_BAR; PG8_MMA(0, 0, At, B0); PG8_MMA(0, 1, At, B1); PG8_BAR; PG8_SCHED;
            PG8_LDA(At, 0, 1); PG8_STAGE(PG8_SB(0, 0), b2, voffB); PG8_STAGE(PG8_SB(0, 1), b2 + hstep, voffB); PG8_STAGE(PG8_SA(0, 0), a2, voffA);
            PG8_WAIT_V(8); PG8_WAIT_L(0); PG8_BAR; PG8_MMA(1, 0, At, B0); PG8_MMA(1, 1, At, B1); PG8_BAR; PG8_SCHED;
            PG8_LDB(B0, 1, 0); PG8_LDB(B1, 1, 1); PG8_SCHED; PG8_LDA(At, 1, 0); PG8_STAGE(PG8_SA(0, 1), a2 + hstep, voffA);
            PG8_WAIT_V(8); PG8_WAIT_L(0); PG8_BAR; PG8_MMA(0, 0, At, B0); PG8_MMA(0, 1, At, B1); PG8_BAR; PG8_SCHED;
            PG8_LDA(At, 1, 1); PG8_STAGE(PG8_SB(1, 0), b3, voffB); PG8_STAGE(PG8_SB(1, 1), b3 + hstep, voffB); PG8_STAGE(PG8_SA(1, 0), a3, voffA);
            PG8_WAIT_V(8); PG8_WAIT_L(0); PG8_BAR; PG8_MMA(1, 0, At, B0); PG8_MMA(1, 1, At, B1); PG8_BAR; PG8_SCHED;
            } else {
            PG8_LDB(B0, 0, 0); PG8_SCHED; PG8_LDA(At, 0, 0); PG8_STAGE(PG8_SA(1, 1), a1 + hstep, voffA);
            PG8_WAIT_L(8); PG8_BAR; PG8_WAIT_L(0); PG8_MMA(0, 0, At, B0); PG8_BAR; PG8_SCHED;
            PG8_LDB(B1, 0, 1); PG8_STAGE(PG8_SB(0, 0), b2, voffB);
            PG8_BAR; PG8_WAIT_L(0); PG8_MMA(0, 1, At, B1); PG8_BAR;
            PG8_LDA(At, 0, 1); PG8_STAGE(PG8_SA(0, 0), a2, voffA);
            PG8_BAR; PG8_WAIT_L(0); PG8_MMA(1, 0, At, B0); PG8_BAR; PG8_SCHED;
            PG8_STAGE(PG8_SB(0, 1), b2 + hstep, voffB);
            PG8_WAIT_V(6); PG8_BAR; PG8_MMA(1, 1, At, B1); PG8_BAR;
            PG8_LDB(B0, 1, 0); PG8_SCHED; PG8_LDA(At, 1, 0); PG8_STAGE(PG8_SA(0, 1), a2 + hstep, voffA);
            PG8_WAIT_L(8); PG8_BAR; PG8_WAIT_L(0); PG8_MMA(0, 0, At, B0); PG8_BAR; PG8_SCHED;
            PG8_LDB(B1, 1, 1); PG8_STAGE(PG8_SB(1, 0), b3, voffB);
            PG8_BAR; PG8_WAIT_L(0); PG8_MMA(0, 1, At, B1); PG8_BAR;
            PG8_LDA(At, 1, 1); PG8_STAGE(PG8_SA(1, 0), a3, voffA);
            PG8_BAR; PG8_WAIT_L(0); PG8_MMA(1, 0, At, B0); PG8_BAR; PG8_SCHED;
            PG8_STAGE(PG8_SB(1, 1), b3 + hstep, voffB);
            PG8_WAIT_V(6); PG8_BAR; PG8_MMA(1, 1, At, B1); PG8_BAR;
            }
        }
        if constexpr (ALIGN_EPI) { if (wr == 0) PG8_BAR; }
        if constexpr (!Epi::AFTER_DRAIN) { E(acc, cur, wr, wc, fr, fq); S.done(cur); }
        if (!has_next) break;
#pragma unroll
        for (int a = 0; a < 2; ++a)
#pragma unroll
            for (int b = 0; b < 2; ++b)
#pragma unroll
                for (int m = 0; m < 4; ++m)
#pragma unroll
                    for (int n = 0; n < 2; ++n) acc[a][b][m][n] = (f32x4){0.f, 0.f, 0.f, 0.f};
        cur = nxt; cA = nA; cB = nB; ++ui;
        if constexpr (ALIGN_EPI) { if (wr == 1) PG8_BAR; }
    }
    PG8_WAIT_V(0);
    if constexpr (!ALIGN_EPI) { if (wr == 0) PG8_BAR; }
    PG8_BAR;
    if constexpr (Epi::AFTER_DRAIN) { E.fused(acc, cur, wr, wc, fr, fq, lds, wid, lane); S.done(cur); }
#undef PG8_SA
#undef PG8_SB
#undef PG8_STAGE
#undef PG8_LDA
#undef PG8_LDB
#undef PG8_MMA
#undef PG8_WAIT_V
#undef PG8_WAIT_L
#undef PG8_BAR
#undef PG8_SCHED
}
}

#define LAS __attribute__((address_space(3)))
typedef unsigned short bf16;
typedef float f32x4 __attribute__((ext_vector_type(4)));
typedef float f32x2 __attribute__((ext_vector_type(2)));
typedef short bf16x8 __attribute__((ext_vector_type(8)));
typedef unsigned u32x4 __attribute__((ext_vector_type(4)));
typedef unsigned u32x2 __attribute__((ext_vector_type(2)));

constexpr int D = 1024, SEQ = 8192, NB = 2, NMETA = 16, MMAIN = NB * SEQ, DIN = 1792, DFF = 4096, NLAYER = 2;
constexpr int C_POOL = 0, C_BVAL = 256, C_BGATE = 512, C_CGATE = 768, C_CX = 1280;
constexpr int DRNN = 512, DCONV = 256, DPOOL = 256, CONVK = 31;
constexpr float EPS = 1e-6f;
constexpr int NWAVES = 8, NTHR = 512;

constexpr size_t MiB = 1u << 20;
constexpr int NROWS = MMAIN + NMETA;
constexpr size_t WS_CTL = 0, CTL_ZERO_BYTES = 65536;
constexpr size_t WS_AGG = 65536;
constexpr size_t WS_PART = 640 * 1024;
constexpr size_t WS_SMALLW = WS_PART + 1088 * 1024;
constexpr size_t SMALLW_LAYER = 288 * 1024;
constexpr size_t SW_POOL = 0, SW_PW = 32 * 1024, SW_WA = 160 * 1024, SW_WX = 224 * 1024;
constexpr size_t WS_WIN = 3 * MiB, WS_WOUT = 10 * MiB, WS_WUP = 14 * MiB, WS_WDN = 30 * MiB;
constexpr size_t WS_HB = 46 * MiB;
constexpr size_t WS_HID = WS_HB + (size_t)NROWS * D * 2 + 4096;
constexpr size_t WS_Y = WS_HID + (size_t)NROWS * DFF * 2 + 4096;
constexpr size_t WS_GP = WS_Y + (size_t)NROWS * D * 2 + 4096;
constexpr size_t WS_END = WS_GP + (size_t)MMAIN * DRNN * 2;
static_assert(WS_END <= 256 * MiB && WS_SMALLW + NLAYER * SMALLW_LAYER <= WS_WIN && WS_PART + (size_t)NROWS * 64 <= WS_SMALLW, "ws map");
static_assert((size_t)NROWS * DIN * 2 <= (size_t)MMAIN * D * 4, "p fits d_out");
constexpr size_t AG_TP = 0, AG_TH = AG_TP + NB * 32 * 512, AG_MP = AG_TH + NB * 32 * 512, AG_MH = AG_MP + 512, AG_LAYER = AG_MH + 512;
static_assert(WS_AGG + NLAYER * AG_LAYER * 4 <= WS_PART, "agg fits");
constexpr int CW_SEAM = 4096, CW_META = CW_SEAM + NLAYER * 4 * 64 * 16;
static_assert((CW_META + NLAYER * 4 * 16) * 4 <= (int)CTL_ZERO_BYTES, "ctl words");
__device__ __forceinline__ unsigned* seam_cnt(unsigned char* ws, int l, int sm, int pm) { return (unsigned*)(ws + WS_CTL) + CW_SEAM + ((l * 4 + sm) * 64 + pm) * 16; }
__device__ __forceinline__ unsigned* meta_cnt(unsigned char* ws, int l, int j) { return (unsigned*)(ws + WS_CTL) + CW_META + (l * 4 + j) * 16; }

constexpr int LDS_BYTES = 147456;
constexpr int ASTRIDE = 544;
constexpr int L_V = 0, L_CA = 0;
constexpr int L_G = 49152, L_PA = 49152;
constexpr int L_W = 98304;
constexpr int L_STATS = 131072;
constexpr int XCSTRIDE = 272, L_XC = 0;
constexpr int L_AGG = 0;
constexpr int L_BARST = LDS_BYTES - 256;
static_assert(L_STATS + 1024 <= L_BARST && L_XC + 256 * XCSTRIDE <= L_BARST && 64 * ASTRIDE <= 49152, "lds map");

__device__ __forceinline__ float bf_lo(unsigned u) { return __uint_as_float(u << 16); }
__device__ __forceinline__ float bf_hi(unsigned u) { return __uint_as_float(u & 0xffff0000u); }
__device__ __forceinline__ unsigned pk_bf16(float lo, float hi) { return pg8::cvt_pk_bf16(lo, hi); }
__device__ __forceinline__ void st16_wt(void* p, u32x4 v) { asm volatile("global_store_dwordx4 %0, %1, off sc1\n\ts_nop 1" :: "v"(p), "v"(v) : "memory"); }
__device__ __forceinline__ float sigm(float x) { return __builtin_amdgcn_rcpf(1.0f + __expf(-x)); }
__device__ __forceinline__ float gelu_tanh(float x) { return x * sigm(1.5957691216f * (x + 0.044715f * x * x * x)); }
__device__ __forceinline__ float wave_sum(float v) {
#pragma unroll
    for (int o = 1; o < 64; o <<= 1) v += __shfl_xor(v, o);
    return v;
}
template <int N> __device__ __forceinline__ float dpp_shr(float old, float x) {
    return __builtin_bit_cast(float, __builtin_amdgcn_update_dpp(__builtin_bit_cast(int, old), __builtin_bit_cast(int, x), 0x110 + N, 0xF, 0xF, false));
}
__device__ __forceinline__ int row_of(int b, int q) { return q < NMETA ? MMAIN + q : b * SEQ + q - NMETA; }

struct Ctx {
    const float* in[23]; float* out; unsigned char* ws;
};

template <bool RELU2> struct EpiScale {
    static constexpr bool PERM = true, AFTER_DRAIN = false;
    bf16* O; int ldc; const float* part;
    __device__ __forceinline__ void operator()(const pg8::f32x4 (&acc)[2][2][4][2], const pg8::Unit& u, int wr, int wc, int fr, int fq) const {
        const int row0 = u.pm * 256 + wr * 64 + fr, col0 = u.pn * 256 + wc * 32 + 8 * fq;
        const int lane = fr + 16 * fq;
        float rsl[2];
#pragma unroll
        for (int ai = 0; ai < 2; ++ai) { const f32x4* pp = (const f32x4*)(part + (size_t)(u.pm * 256 + ai * 128 + wr * 64 + lane) * 16);
            const f32x4 s4 = (pp[0] + pp[1]) + (pp[2] + pp[3]);
            rsl[ai] = __builtin_amdgcn_rsqf(((s4.x + s4.y) + (s4.z + s4.w)) * (1.0f / D) + EPS); }
        asm volatile("" ::: "memory");
#pragma unroll
        for (int ai = 0; ai < 2; ++ai)
#pragma unroll
            for (int m = 0; m < 4; ++m) {
                const int row = row0 + ai * 128 + m * 16;
                const float rs = __shfl(rsl[ai], 16 * m + fr);
                bf16* rowp = O + (size_t)row * ldc + col0;
#pragma unroll
                for (int bj = 0; bj < 2; ++bj) {
                    f32x4 v0 = acc[ai][bj][m][0] * rs, v1 = acc[ai][bj][m][1] * rs;
                    if (RELU2) {
#pragma unroll
                        for (int j = 0; j < 4; ++j) { const float a0 = fmaxf(v0[j], 0.f), a1 = fmaxf(v1[j], 0.f); v0[j] = a0 * a0; v1[j] = a1 * a1; }
                    }
                    u32x4 w; w.x = pk_bf16(v0[0], v0[1]); w.y = pk_bf16(v0[2], v0[3]); w.z = pk_bf16(v1[0], v1[1]); w.w = pk_bf16(v1[2], v1[3]);
                    st16_wt(rowp + bj * 128, w);
                }
            }
    }
};
struct EpiResid {
    static constexpr bool PERM = true, AFTER_DRAIN = false;
    const bf16* hin; bf16* hb; float* part;
    __device__ __forceinline__ void operator()(const pg8::f32x4 (&acc)[2][2][4][2], const pg8::Unit& u, int wr, int wc, int fr, int fq) const {
        const int row0 = u.pm * 256 + wr * 64 + fr, col0 = u.pn * 256 + wc * 32 + 8 * fq;
#pragma unroll
        for (int ai = 0; ai < 2; ++ai)
#pragma unroll
            for (int m = 0; m < 4; ++m) {
                const int row = row0 + ai * 128 + m * 16;
                bf16* brow = hb + (size_t)row * D + col0; const bf16* irow = hin + (size_t)row * D + col0;
                const u32x4 h0 = *(const u32x4*)(irow), h1 = *(const u32x4*)(irow + 128);
                float ss = 0.f;
#pragma unroll
                for (int bj = 0; bj < 2; ++bj) {
                    const u32x4 hr = bj ? h1 : h0;
                    const f32x4 r0 = (f32x4){bf_lo(hr.x), bf_hi(hr.x), bf_lo(hr.y), bf_hi(hr.y)}, r1 = (f32x4){bf_lo(hr.z), bf_hi(hr.z), bf_lo(hr.w), bf_hi(hr.w)};
                    const f32x4 v0 = acc[ai][bj][m][0] + r0, v1 = acc[ai][bj][m][1] + r1;
                    u32x4 w; w.x = pk_bf16(v0[0], v0[1]); w.y = pk_bf16(v0[2], v0[3]); w.z = pk_bf16(v1[0], v1[1]); w.w = pk_bf16(v1[2], v1[3]);
                    st16_wt(brow + bj * 128, w);
                    ss += (v0[0] * v0[0] + v0[1] * v0[1]) + (v0[2] * v0[2] + v0[3] * v0[3]) + (v1[0] * v1[0] + v1[1] * v1[1]) + (v1[2] * v1[2] + v1[3] * v1[3]);
                }
                ss += __shfl_xor(ss, 16); ss += __shfl_xor(ss, 32);
                if (fq == 0) part[(size_t)row * 16 + u.pn * 4 + wc] = ss;
                if (m & 1) asm volatile("" ::: "memory");
            }
    }
};

template <int MODE  >
__device__ __forceinline__ void skinny_task(const bf16* A, const bf16* Bt, int K, int task, bf16* O, int ldo, float* part, LAS unsigned char* lds) {
    const int tid = pg8::opaque_tid(), wid = __builtin_amdgcn_readfirstlane(tid >> 6), lane = tid & 63, fr = lane & 15, fq = lane >> 4;
    const int n0 = task * 64, kw = K / 8, k0 = wid * kw;
    pg8::f32x4 acc[4];
#pragma unroll
    for (int n = 0; n < 4; ++n) acc[n] = (pg8::f32x4){0.f, 0.f, 0.f, 0.f};
    const bf16* ap = A + (size_t)fr * K + k0 + 8 * fq; const bf16* bp = Bt + (size_t)(n0 + fr) * K + k0 + 8 * fq;
#pragma unroll 4
    for (int k = 0; k < kw; k += 32) {
        const bf16x8 a = *(const bf16x8*)(ap + k);
#pragma unroll
        for (int n = 0; n < 4; ++n) { const bf16x8 bf = *(const bf16x8*)(bp + (size_t)(16 * n) * K + k); acc[n] = __builtin_amdgcn_mfma_f32_16x16x32_bf16(bf, a, acc[n], 0, 0, 0); }
    }
    LAS f32x4* red = (LAS f32x4*)lds;
#pragma unroll
    for (int n = 0; n < 4; ++n) red[(wid * 4 + n) * 64 + lane] = (f32x4){acc[n][0], acc[n][1], acc[n][2], acc[n][3]};
    __syncthreads();
    if (wid == 0) {
        f32x4 sv[4];
#pragma unroll
        for (int n = 0; n < 4; ++n) { sv[n] = red[n * 64 + lane];
#pragma unroll
            for (int w = 1; w < 8; ++w) sv[n] += red[(w * 4 + n) * 64 + lane]; }
        const int row = MMAIN + fr;
        if (MODE < 2) {
            const f32x4* pp = (const f32x4*)(part + (size_t)row * 16);
            const f32x4 s4 = (pp[0] + pp[1]) + (pp[2] + pp[3]);
            const float rs = __builtin_amdgcn_rsqf(((s4.x + s4.y) + (s4.z + s4.w)) * (1.0f / D) + EPS);
#pragma unroll
            for (int n = 0; n < 4; ++n) { f32x4 v = sv[n] * rs;
                if (MODE == 1) {
#pragma unroll
                    for (int j = 0; j < 4; ++j) { const float a0 = fmaxf(v[j], 0.f); v[j] = a0 * a0; } }
                u32x2 w; w.x = pk_bf16(v[0], v[1]); w.y = pk_bf16(v[2], v[3]);
                *(u32x2*)(O + (size_t)row * ldo + n0 + 16 * n + 4 * fq) = w; }
        } else {
            float ss = 0.f;
#pragma unroll
            for (int n = 0; n < 4; ++n) { bf16* op = O + (size_t)row * ldo + n0 + 16 * n + 4 * fq; const u32x2 hr = *(const u32x2*)op;
                const f32x4 v = sv[n] + (f32x4){bf_lo(hr.x), bf_hi(hr.x), bf_lo(hr.y), bf_hi(hr.y)};
                u32x2 w; w.x = pk_bf16(v[0], v[1]); w.y = pk_bf16(v[2], v[3]); *(u32x2*)op = w;
                ss += (v[0] * v[0] + v[1] * v[1]) + (v[2] * v[2] + v[3] * v[3]); }
            ss += __shfl_xor(ss, 16); ss += __shfl_xor(ss, 32);
            if (fq == 0) part[(size_t)row * 16 + task] = ss;
        }
    }
    __syncthreads();
}

struct TrItem { const float* W; bf16* WT; const float* gk; int K, N, item; };
__device__ __forceinline__ void tr_load(const TrItem& t, int lane, f32x4 (&tv)[8]) {
    const int nblk = t.N / 32, kb = t.item / nblk, nb = t.item % nblk, k0 = 64 * kb, n0 = 32 * nb;
#pragma unroll
    for (int i = 0; i < 8; ++i) { const int kk = 8 * i + (lane >> 3); tv[i] = *(const f32x4*)(t.W + (size_t)(k0 + kk) * t.N + n0 + 4 * (lane & 7)); if (t.gk) tv[i] = tv[i] * t.gk[k0 + kk]; }
}
__device__ __forceinline__ void tr_store(const TrItem& t, int lane, const f32x4 (&tv)[8], LAS float* scr) {
    const int nblk = t.N / 32, kb = t.item / nblk, nb = t.item % nblk, k0 = 64 * kb, n0 = 32 * nb;
#pragma unroll
    for (int i = 0; i < 8; ++i) { const int kk = 8 * i + (lane >> 3); LAS float* d = scr + kk * 33 + 4 * (lane & 7); d[0] = tv[i].x; d[1] = tv[i].y; d[2] = tv[i].z; d[3] = tv[i].w; }
    asm volatile("s_waitcnt lgkmcnt(0)" ::: "memory");
    const int c = lane & 7;
#pragma unroll
    for (int j = 0; j < 4; ++j) { const int n = (lane >> 3) + 8 * j; const LAS float* sp = scr + (8 * c) * 33 + n;
        u32x4 o; o.x = pk_bf16(sp[0 * 33], sp[1 * 33]); o.y = pk_bf16(sp[2 * 33], sp[3 * 33]); o.z = pk_bf16(sp[4 * 33], sp[5 * 33]); o.w = pk_bf16(sp[6 * 33], sp[7 * 33]);
        *(u32x4*)(t.WT + (size_t)(n0 + n) * t.K + k0 + 8 * c) = o; }
    asm volatile("s_waitcnt lgkmcnt(0)" ::: "memory");
}
constexpr int I_IN = 16 * 56, I_OUT = 16 * 32, I_UP = 16 * 128, I_DN = 64 * 32, I_POOL = 4 * 2, I_PW = 4 * 8, I_WA = 8 * 2, I_WX = 8 * 2;
constexpr int I_LAYER = I_IN + I_OUT + I_UP + I_DN + I_POOL + I_PW + I_WA + I_WX;
__device__ __forceinline__ TrItem tr_desc(const Ctx& C, int l, int r) {
    unsigned char* ws = C.ws; bf16* sw = (bf16*)(ws + WS_SMALLW + l * SMALLW_LAYER);
    if (r < I_IN) return TrItem{C.in[3] + (size_t)l * D * DIN, (bf16*)(ws + WS_WIN) + (size_t)l * D * DIN, C.in[2] + l * D, D, DIN, r}; r -= I_IN;
    if (r < I_OUT) return TrItem{C.in[18] + (size_t)l * D * D, (bf16*)(ws + WS_WOUT) + (size_t)l * D * D, nullptr, D, D, r}; r -= I_OUT;
    if (r < I_UP) return TrItem{C.in[20] + (size_t)l * D * DFF, (bf16*)(ws + WS_WUP) + (size_t)l * D * DFF, C.in[19] + l * D, D, DFF, r}; r -= I_UP;
    if (r < I_DN) return TrItem{C.in[21] + (size_t)l * DFF * D, (bf16*)(ws + WS_WDN) + (size_t)l * DFF * D, nullptr, DFF, D, r}; r -= I_DN;
    if (r < I_POOL) { const int g = r >> 1; return TrItem{C.in[4] + (size_t)(l * 4 + g) * 4096, sw + SW_POOL / 2 + g * 4096, nullptr, 64, 64, r & 1}; } r -= I_POOL;
    if (r < I_PW) return TrItem{C.in[10] + (size_t)l * 65536, sw + SW_PW / 2, nullptr, 256, 256, r}; r -= I_PW;
    if (r < I_WA) { const int h = r >> 1; return TrItem{C.in[13] + (size_t)(l * 8 + h) * 4096, sw + SW_WA / 2 + h * 4096, nullptr, 64, 64, r & 1}; } r -= I_WA;
    { const int h = r >> 1; return TrItem{C.in[15] + (size_t)(l * 8 + h) * 4096, sw + SW_WX / 2 + h * 4096, nullptr, 64, 64, r & 1}; }
}
__device__ __forceinline__ void p0_prologue(const Ctx& C, LAS unsigned char* lds, int l_lo, int l_hi, int rows, int vb, int nb) {
    const int tid = pg8::opaque_tid(), lane = tid & 63, wave = tid >> 6;
    LAS float* scr = (LAS float*)(lds + wave * 16384);
    const int gw = vb * NWAVES + wave, NGW = nb * NWAVES;
    unsigned char* ws = C.ws;
    const int nit = (l_hi - l_lo) * I_LAYER;
#pragma unroll 1
    for (int it = gw; it < nit; it += 2 * NGW) {
        const int it2 = it + NGW; const bool two = it2 < nit;
        const TrItem ta = tr_desc(C, l_lo + it / I_LAYER, it % I_LAYER), tb = tr_desc(C, l_lo + (two ? it2 : it) / I_LAYER, (two ? it2 : it) % I_LAYER);
        f32x4 va[8], vb8[8];
        tr_load(ta, lane, va); if (two) tr_load(tb, lane, vb8);
        tr_store(ta, lane, va, scr); if (two) tr_store(tb, lane, vb8, scr);
    }
    bf16* hb = (bf16*)(ws + WS_HB); float* part = (float*)(ws + WS_PART);
    if (rows) for (int m0 = gw; m0 < MMAIN + NMETA; m0 += 2 * NGW) {
        f32x4 v[2][4]; float sq[2];
#pragma unroll
        for (int u = 0; u < 2; ++u) { const int m = m0 + u * NGW; if (m < MMAIN + NMETA) {
            const float* src = m < MMAIN ? C.in[0] + (size_t)m * D : C.in[1] + (size_t)(m - MMAIN) * D;
#pragma unroll
            for (int j = 0; j < 4; ++j) v[u][j] = ((const f32x4*)src)[lane + 64 * j]; } }
#pragma unroll
        for (int u = 0; u < 2; ++u) { const int m = m0 + u * NGW; if (m < MMAIN + NMETA) {
            float s = 0.f;
#pragma unroll
            for (int j = 0; j < 4; ++j) s += (v[u][j].x * v[u][j].x + v[u][j].y * v[u][j].y) + (v[u][j].z * v[u][j].z + v[u][j].w * v[u][j].w);
            sq[u] = wave_sum(s);
#pragma unroll
            for (int j = 0; j < 4; ++j) { u32x2 w; w.x = pk_bf16(v[u][j].x, v[u][j].y); w.y = pk_bf16(v[u][j].z, v[u][j].w); ((u32x2*)(hb + (size_t)m * D))[lane + 64 * j] = w; }
            if (lane < 16) part[(size_t)m * 16 + lane] = lane == 0 ? sq[u] : 0.f; } }
    }
}

template <int CTRL> __device__ __forceinline__ float dpp_mov(float x) {
    return __builtin_bit_cast(float, __builtin_amdgcn_update_dpp(0, __builtin_bit_cast(int, x), CTRL, 0xF, 0xF, true));
}
__device__ __forceinline__ float wave_sum_fast(float v) {
    v += dpp_mov<0xB1>(v); v += dpp_mov<0x4E>(v); v += dpp_mov<0x141>(v); v += dpp_mov<0x140>(v);
    v += __shfl_xor(v, 16); v += __shfl_xor(v, 32);
    return v;
}
#ifndef PROBE_CPS
#define PROBE_CPS 0
#endif
__device__ __forceinline__ void convpool_item(const Ctx& C, int l, int b, int pos0, int nvalid, LAS unsigned char* lds) {
    const int tid = pg8::opaque_tid(), lane = tid & 63, wid = __builtin_amdgcn_readfirstlane(tid >> 6), fr = lane & 15, fq = lane >> 4;
    const int cp = (wid & 1) * 64 + lane, tg = wid >> 1;
    const bf16* P = (const bf16*)C.out; bf16* Y = (bf16*)(C.ws + WS_Y);
    const bf16* sw = (const bf16*)(C.ws + WS_SMALLW + l * SMALLW_LAYER);
    const bool act = tg * 16 < nvalid;
    const int nrows = nvalid + 30;
    const int pg = wid & 3, pth = wid >> 2, pch = 64 * pg + lane;
    const bool pact = pth * 32 < nvalid;
    float xr[47];
    if (pact) {
        unsigned xraw[47];
#pragma unroll
        for (int i = 0; i < 47; ++i) { const int q = pos0 + pth * 32 - 15 + i; xraw[i] = *(const unsigned short*)(P + (size_t)row_of(b, max(q, 0)) * DIN + C_POOL + pch); }
#pragma unroll
        for (int i = 0; i < 47; ++i) asm volatile("" : "+v"(xraw[i]));
#pragma unroll
        for (int i = 0; i < 47; ++i) { const int q = pos0 + pth * 32 - 15 + i; xr[i] = q >= 0 ? __uint_as_float(xraw[i] << 16) : 0.f; }
    }
#pragma unroll 1
    for (int prr = 0; prr <= (PROBE_CPS == 1); ++prr) {
    if (prr) { asm volatile("s_waitcnt vmcnt(0)" ::: "memory"); __syncthreads(); }
#pragma unroll 1
    for (int pi = wid; pi < 127; pi += NWAVES) {
        const char* gp; int loff;
        if (pi < 96) { const int isg = pi >= 48, pr = (isg ? pi - 48 : pi) * 2 + (lane >> 5); const int q = pos0 - 30 + pr;
            gp = (const char*)(P + (size_t)row_of(b, max(q, 0)) * DIN + (isg ? C_BGATE : C_BVAL) + (lane & 31) * 8); loff = (isg ? L_G : L_V) + (pr & ~1) * 512; }
        else { const int k = pi - 96; gp = (const char*)(C.in[6] + ((size_t)l * CONVK + k) * DCONV + lane * 4); loff = L_W + k * 1024; }
        __builtin_amdgcn_global_load_lds((const unsigned*)gp, (LAS unsigned*)(lds + __builtin_amdgcn_readfirstlane(loff)), 16, 0, 0);
    }
    }
    if (tid < 256) *(LAS float*)(lds + L_W + 31 * 1024 + tid * 4) = 0.f;
    const f32x2 bias = *(const f32x2*)(C.in[7] + l * DCONV + 2 * cp);
    const f32x2 lg = *(const f32x2*)(C.in[8] + l * DCONV + 2 * cp), lb = *(const f32x2*)(C.in[9] + l * DCONV + 2 * cp);
    asm volatile("s_waitcnt vmcnt(0)" ::: "memory");
    __syncthreads();
#pragma unroll 2
    for (int i = 0; i < 24; ++i) { const int r = tg + 4 * i; const int q = pos0 - 30 + r;
        const unsigned vv = *(const LAS unsigned*)(lds + L_V + r * 512 + cp * 4), gg = *(const LAS unsigned*)(lds + L_G + r * 512 + cp * 4);
        const bool ok = q >= 0 && r < nrows;
        *(LAS unsigned*)(lds + L_V + r * 512 + cp * 4) = ok ? pk_bf16(bf_lo(vv) * sigm(bf_lo(gg)), bf_hi(vv) * sigm(bf_hi(gg))) : 0u; }
    __syncthreads();
    if (pact) {
#pragma unroll 1
        for (int prr = 0; prr <= (PROBE_CPS == 6); ++prr) {
#define POOL_BODY(W) do { float sum = 0.f; \
        _Pragma("unroll") for (int d = 1; d < (W); ++d) sum += xr[15 - d]; \
        _Pragma("unroll") for (int j = 0; j < 32; ++j) { const int i = j + 15; sum += xr[i]; \
            const int q = pos0 + pth * 32 + j; const float inv = __builtin_amdgcn_rcpf((float)min(q + 1, (W))); const float o = sum * inv - xr[i]; \
            *(LAS unsigned short*)(lds + L_PA + (pth * 32 + j) * ASTRIDE + pch * 2) = (unsigned short)(pk_bf16(o, 0.f) & 0xffffu); \
            sum -= xr[i - (W) + 1]; } } while (0)
        if (pg == 0) POOL_BODY(2); else if (pg == 1) POOL_BODY(4); else if (pg == 2) POOL_BODY(8); else POOL_BODY(16);
#undef POOL_BODY
        }
    }
    f32x2 acc[16];
    if (act) {
#pragma unroll 1
        for (int prr = 0; prr <= (PROBE_CPS == 2); ++prr) {
#pragma unroll
        for (int j = 0; j < 16; ++j) acc[j] = bias;
#pragma unroll 1
        for (int kc = 0; kc < 8; ++kc) {
            f32x2 w4[4], u[19];
#pragma unroll
            for (int t = 0; t < 4; ++t) w4[t] = *(const LAS f32x2*)(lds + L_W + (4 * kc + t) * 1024 + cp * 8);
#pragma unroll
            for (int i = 0; i < 19; ++i) { const unsigned uu = *(const LAS unsigned*)(lds + L_V + (tg * 16 + 4 * kc + i) * 512 + cp * 4); u[i] = (f32x2){bf_lo(uu), bf_hi(uu)}; }
#pragma unroll
            for (int j = 0; j < 16; ++j)
#pragma unroll
                for (int t = 0; t < 4; ++t) acc[j] += w4[t] * u[j + t];
        }
        }
#pragma unroll 1
        for (int prr = 0; prr <= (PROBE_CPS == 3); ++prr)
#pragma unroll
        for (int j = 0; j < 16; ++j) {
            const float s1 = wave_sum_fast(acc[j].x + acc[j].y), sq = wave_sum_fast(acc[j].x * acc[j].x + acc[j].y * acc[j].y);
            if (lane == 0) *(LAS f32x2*)(lds + L_STATS + ((tg * 16 + j) * 2 + (wid & 1)) * 8) = (f32x2){s1, sq};
        }
    }
    const int n0 = 32 * wid, g4 = wid >> 1, d0 = n0 & 63;
    const bf16* pwt = sw + SW_PW / 2; const bf16* plt = sw + SW_POOL / 2 + g4 * 4096;
    bf16x8 Bp[8][2], Bq[2][2];
#pragma unroll
    for (int kk = 0; kk < 8; ++kk)
#pragma unroll
        for (int n = 0; n < 2; ++n) Bp[kk][n] = *(const bf16x8*)(pwt + (size_t)(n0 + 16 * n + fr) * 256 + 32 * kk + 8 * fq);
#pragma unroll
    for (int kk = 0; kk < 2; ++kk)
#pragma unroll
        for (int n = 0; n < 2; ++n) Bq[kk][n] = *(const bf16x8*)(plt + (size_t)(d0 + 16 * n + fr) * 64 + 32 * kk + 8 * fq);
    __syncthreads();
    if (act) {
#pragma unroll 1
        for (int prr = 0; prr <= (PROBE_CPS == 7); ++prr)
#pragma unroll
        for (int j = 0; j < 16; ++j) {
            const f32x4 st = *(LAS f32x4*)(lds + L_STATS + (tg * 16 + j) * 16);
            const float mean = (st.x + st.z) * (1.0f / DCONV), var = fmaxf((st.y + st.w) * (1.0f / DCONV) - mean * mean, 0.f), rstd = __builtin_amdgcn_rsqf(var + EPS);
            f32x2 y = (acc[j] - mean) * rstd * lg + lb;
            y.x = y.x * sigm(y.x); y.y = y.y * sigm(y.y);
            *(LAS unsigned*)(lds + L_CA + (tg * 16 + j) * ASTRIDE + cp * 4) = pk_bf16(y.x, y.y);
        }
    }
    __syncthreads();
#pragma unroll 1
    for (int prr = 0; prr <= (PROBE_CPS == 4); ++prr)
    {
        pg8::f32x4 accb[4][2], acca[4][2];
#pragma unroll
        for (int m = 0; m < 4; ++m)
#pragma unroll
            for (int n = 0; n < 2; ++n) { accb[m][n] = (pg8::f32x4){0.f, 0.f, 0.f, 0.f}; acca[m][n] = (pg8::f32x4){0.f, 0.f, 0.f, 0.f}; }
#pragma unroll
        for (int kk = 0; kk < 8; ++kk) {
#pragma unroll
            for (int m = 0; m < 4; ++m) { if (16 * m >= nvalid) continue; const bf16x8 Af = *(const LAS bf16x8*)(lds + L_CA + (16 * m + fr) * ASTRIDE + (32 * kk + 8 * fq) * 2);
#pragma unroll
                for (int n = 0; n < 2; ++n) accb[m][n] = __builtin_amdgcn_mfma_f32_16x16x32_bf16(Bp[kk][n], Af, accb[m][n], 0, 0, 0); }
        }
#pragma unroll
        for (int kk = 0; kk < 2; ++kk) {
#pragma unroll
            for (int m = 0; m < 4; ++m) { if (16 * m >= nvalid) continue; const bf16x8 Af = *(const LAS bf16x8*)(lds + L_PA + (16 * m + fr) * ASTRIDE + (64 * g4 + 32 * kk + 8 * fq) * 2);
#pragma unroll
                for (int n = 0; n < 2; ++n) acca[m][n] = __builtin_amdgcn_mfma_f32_16x16x32_bf16(Bq[kk][n], Af, acca[m][n], 0, 0, 0); }
        }
        const float* psc = C.in[5] + l * DPOOL;
        f32x4 sc[2];
#pragma unroll
        for (int n = 0; n < 2; ++n) sc[n] = *(const f32x4*)(psc + n0 + 16 * n + 4 * fq);
#pragma unroll
        for (int m = 0; m < 4; ++m) { const int tok = 16 * m + fr;
            if (tok < nvalid) { bf16* yr = Y + (size_t)row_of(b, pos0 + tok) * D;
#pragma unroll
                for (int n = 0; n < 2; ++n) { const int col = n0 + 16 * n + 4 * fq;
                    const pg8::f32x4 a = acca[m][n], c = accb[m][n];
                    u32x2 wa; wa.x = pk_bf16(a[0] * sc[n].x, a[1] * sc[n].y); wa.y = pk_bf16(a[2] * sc[n].z, a[3] * sc[n].w);
                    u32x2 wb; wb.x = pk_bf16(c[0], c[1]); wb.y = pk_bf16(c[2], c[3]);
                    *(u32x2*)(yr + col) = wa; *(u32x2*)(yr + DPOOL + col) = wb; } } }
    }
    __syncthreads();
}

__device__ __forceinline__ void rg_item(const Ctx& C, int l, int b, int pos0, int nvalid, int hp, int tile, LAS unsigned char* lds) {
    const int tid = pg8::opaque_tid(), lane = tid & 63, wid = __builtin_amdgcn_readfirstlane(tid >> 6), fr = lane & 15, fq = lane >> 4;
    const int hsel = wid >> 2, nt = wid & 3, hh = 2 * hp + hsel, cb = 64 * hh, c0 = 16 * nt + 4 * fq, cl = hsel * 64 + c0;
    const bf16* P = (const bf16*)C.out; bf16* Y = (bf16*)(C.ws + WS_Y); bf16* GPb = (bf16*)(C.ws + WS_GP);
    const bf16* sw = (const bf16*)(C.ws + WS_SMALLW + l * SMALLW_LAYER);
    float* agg = (float*)(C.ws + WS_AGG) + (size_t)l * AG_LAYER;
    const int mcnt = (nvalid + 15) >> 4;
    {
        const int cg = tid & 15, tq = tid >> 4, cx = 128 * hp + 8 * cg;
        if (8 * tq < 16 * mcnt) {
            f32x4 wk[4][2];
#pragma unroll
            for (int k = 0; k < 4; ++k) { wk[k][0] = *(const f32x4*)(C.in[11] + (size_t)(l * 4 + k) * DRNN + cx); wk[k][1] = *(const f32x4*)(C.in[11] + (size_t)(l * 4 + k) * DRNN + cx + 4); }
            const f32x4 bs0 = *(const f32x4*)(C.in[12] + l * DRNN + cx), bs1 = *(const f32x4*)(C.in[12] + l * DRNN + cx + 4);
            u32x4 xr[11];
#pragma unroll
            for (int i = 0; i < 11; ++i) { const int q = pos0 + 8 * tq - 3 + i; const u32x4 raw = *(const u32x4*)(P + (size_t)row_of(b, max(q, 0)) * DIN + C_CX + cx); xr[i] = q >= 0 ? raw : (u32x4){0u, 0u, 0u, 0u}; }
#pragma unroll
            for (int t = 0; t < 8; ++t) {
                f32x4 a0 = bs0, a1 = bs1;
#pragma unroll
                for (int k = 0; k < 4; ++k) { const u32x4 raw = xr[t + k];
                    a0 += wk[k][0] * (f32x4){bf_lo(raw.x), bf_hi(raw.x), bf_lo(raw.y), bf_hi(raw.y)};
                    a1 += wk[k][1] * (f32x4){bf_lo(raw.z), bf_hi(raw.z), bf_lo(raw.w), bf_hi(raw.w)}; }
                u32x4 pk; pk.x = pk_bf16(a0.x, a0.y); pk.y = pk_bf16(a0.z, a0.w); pk.z = pk_bf16(a1.x, a1.y); pk.w = pk_bf16(a1.z, a1.w);
                *(LAS u32x4*)(lds + L_XC + (8 * tq + t) * XCSTRIDE + cg * 16) = pk;
            }
        }
    }
    const int cgl = DRNN * l + cb + c0;
    const f32x4 ba = *(const f32x4*)(C.in[14] + cgl), bx = *(const f32x4*)(C.in[16] + cgl), lam = *(const f32x4*)(C.in[17] + cgl);
    f32x4 sp;
#pragma unroll
    for (int v = 0; v < 4; ++v) sp[v] = 8.0f * log1pf(__expf(-lam[v]));
    bf16x8 Ba[2], Bx[2];
#pragma unroll
    for (int kk = 0; kk < 2; ++kk) { const size_t o = (size_t)(hh * 64 + 16 * nt + fr) * 64 + 32 * kk + 8 * fq; Ba[kk] = *(const bf16x8*)(sw + SW_WA / 2 + o); Bx[kk] = *(const bf16x8*)(sw + SW_WX / 2 + o); }
    u32x2 gnext = *(const u32x2*)(P + (size_t)row_of(b, pos0 + fr) * DIN + C_CGATE + cb + c0);
    __syncthreads();
    f32x4 cP = (f32x4){1.f, 1.f, 1.f, 1.f}, cH = (f32x4){0.f, 0.f, 0.f, 0.f};
    const int bsrc = (lane & 48) | 15;
#pragma unroll 1
    for (int m = 0; m < mcnt; ++m) {
        const int tok = 16 * m + fr; const bool valid = tok < nvalid;
        const size_t row = (size_t)row_of(b, pos0 + tok);
        const u32x2 graw = gnext;
        if (m + 1 < mcnt) gnext = *(const u32x2*)(P + (size_t)row_of(b, pos0 + tok + 16) * DIN + C_CGATE + cb + c0);
        pg8::f32x4 ga = (pg8::f32x4){0.f, 0.f, 0.f, 0.f}, gx = (pg8::f32x4){0.f, 0.f, 0.f, 0.f};
#pragma unroll
        for (int kk = 0; kk < 2; ++kk) { const bf16x8 Af = *(const LAS bf16x8*)(lds + L_XC + tok * XCSTRIDE + (hsel * 64 + 32 * kk + 8 * fq) * 2);
            ga = __builtin_amdgcn_mfma_f32_16x16x32_bf16(Ba[kk], Af, ga, 0, 0, 0); gx = __builtin_amdgcn_mfma_f32_16x16x32_bf16(Bx[kk], Af, gx, 0, 0, 0); }
        const u32x2 xraw = *(const LAS u32x2*)(lds + L_XC + tok * XCSTRIDE + cl * 2);
        const f32x4 xc = (f32x4){bf_lo(xraw.x), bf_hi(xraw.x), bf_lo(xraw.y), bf_hi(xraw.y)};
        const f32x4 gt = (f32x4){bf_lo(graw.x), bf_hi(graw.x), bf_lo(graw.y), bf_hi(graw.y)};
        f32x4 Pt, Ht;
#pragma unroll
        for (int v = 0; v < 4; ++v) {
            const float r = sigm(ga[v] + ba[v]), ig = sigm(gx[v] + bx[v]);
            float a = __expf(-r * sp[v]);
            float bb = __builtin_amdgcn_sqrtf(fmaxf(1.0f - a * a, 0.f)) * ig * xc[v];
            if (!valid) { a = 1.0f; bb = 0.0f; }
            { float ap = dpp_shr<1>(1.0f, a), bp = dpp_shr<1>(0.0f, bb); bb = bb + a * bp; a = a * ap; }
            { float ap = dpp_shr<2>(1.0f, a), bp = dpp_shr<2>(0.0f, bb); bb = bb + a * bp; a = a * ap; }
            { float ap = dpp_shr<4>(1.0f, a), bp = dpp_shr<4>(0.0f, bb); bb = bb + a * bp; a = a * ap; }
            { float ap = dpp_shr<8>(1.0f, a), bp = dpp_shr<8>(0.0f, bb); bb = bb + a * bp; a = a * ap; }
            Pt[v] = a * cP[v]; Ht[v] = bb + a * cH[v];
        }
        if (valid) {
            f32x4 G;
#pragma unroll
            for (int v = 0; v < 4; ++v) G[v] = gelu_tanh(gt[v]);
            u32x2 w1; w1.x = pk_bf16(G[0] * Ht[0], G[1] * Ht[1]); w1.y = pk_bf16(G[2] * Ht[2], G[3] * Ht[3]);
            u32x2 w2; w2.x = pk_bf16(G[0] * Pt[0], G[1] * Pt[1]); w2.y = pk_bf16(G[2] * Pt[2], G[3] * Pt[3]);
            *(u32x2*)(Y + row * D + 512 + cb + c0) = w1; if (tile >= 0) *(u32x2*)(GPb + row * DRNN + cb + c0) = w2;
        }
#pragma unroll
        for (int v = 0; v < 4; ++v) { cP[v] = __shfl(Pt[v], bsrc); cH[v] = __shfl(Ht[v], bsrc); }
    }
    if (fr == 0) {
        if (tile >= 0) { const size_t o = ((size_t)b * 32 + tile) * 512 + cb + c0; *(f32x4*)(agg + AG_TP + o) = cP; *(f32x4*)(agg + AG_TH + o) = cH; }
        else { *(f32x4*)(agg + AG_MP + cb + c0) = cP; *(f32x4*)(agg + AG_MH + cb + c0) = cH; }
    }
    __syncthreads();
}

__device__ __forceinline__ void rg_fix_item(const Ctx& C, int l, int b, int tile, int hp, bf16* Yout) {
    const int tid = pg8::opaque_tid(), lane = tid & 63, wid = __builtin_amdgcn_readfirstlane(tid >> 6);
    const int hsel = wid & 1, s = wid >> 1, c = 64 * (2 * hp + hsel) + 8 * (lane & 7), r8 = lane >> 3;
    const bf16* Y = (const bf16*)(C.ws + WS_Y); const bf16* GPb = (const bf16*)(C.ws + WS_GP); const float* agg = (const float*)(C.ws + WS_AGG) + (size_t)l * AG_LAYER;
    f32x4 H0 = *(const f32x4*)(agg + AG_MH + c), H1 = *(const f32x4*)(agg + AG_MH + c + 4);
#pragma unroll 8
    for (int jj = 0; jj < tile; ++jj) { const size_t o = ((size_t)b * 32 + jj) * 512 + c;
        const f32x4 p0 = *(const f32x4*)(agg + AG_TP + o), p1 = *(const f32x4*)(agg + AG_TP + o + 4), h0 = *(const f32x4*)(agg + AG_TH + o), h1 = *(const f32x4*)(agg + AG_TH + o + 4);
        H0 = h0 + p0 * H0; H1 = h1 + p1 * H1; }
#pragma unroll 8
    for (int it = 0; it < 8; ++it) {
        const size_t row = (size_t)b * SEQ + tile * 256 + 64 * s + 8 * it + r8;
        const u32x4 gh = *(const u32x4*)(Y + row * D + 512 + c), gp = *(const u32x4*)(GPb + row * DRNN + c);
        u32x4 o;
        o.x = pk_bf16(bf_lo(gh.x) + bf_lo(gp.x) * H0.x, bf_hi(gh.x) + bf_hi(gp.x) * H0.y);
        o.y = pk_bf16(bf_lo(gh.y) + bf_lo(gp.y) * H0.z, bf_hi(gh.y) + bf_hi(gp.y) * H0.w);
        o.z = pk_bf16(bf_lo(gh.z) + bf_lo(gp.z) * H1.x, bf_hi(gh.z) + bf_hi(gp.z) * H1.y);
        o.w = pk_bf16(bf_lo(gh.w) + bf_lo(gp.w) * H1.z, bf_hi(gh.w) + bf_hi(gp.w) * H1.w);
        st16_wt(Yout + row * D + 512 + c, o);
    }
}

__device__ __forceinline__ void final_norm(const Ctx& C) {
    const int tid = pg8::opaque_tid(), lane = tid & 63, wave = tid >> 6;
    const int gw = blockIdx.x * NWAVES + wave, NGW = gridDim.x * NWAVES;
    const float* part = (const float*)(C.ws + WS_PART);
    f32x4 g[4];
#pragma unroll
    for (int j = 0; j < 4; ++j) g[j] = ((const f32x4*)C.in[22])[lane + 64 * j];
    for (int m0 = gw; m0 < MMAIN; m0 += 4 * NGW) {
        f32x4 s4[4]; u32x2 h[4][4];
#pragma unroll
        for (int u = 0; u < 4; ++u) { const int m = min(m0 + u * NGW, MMAIN - 1); const f32x4* pp = (const f32x4*)(part + (size_t)m * 16); s4[u] = (pp[0] + pp[1]) + (pp[2] + pp[3]);
            const u32x2* hr = (const u32x2*)((const bf16*)(C.ws + WS_HB) + (size_t)m * D);
#pragma unroll
            for (int j = 0; j < 4; ++j) h[u][j] = hr[lane + 64 * j]; }
#pragma unroll
        for (int u = 0; u < 4; ++u) { const int m = m0 + u * NGW; if (m < MMAIN) {
            const float rs = __builtin_amdgcn_rsqf(((s4[u].x + s4[u].y) + (s4[u].z + s4[u].w)) * (1.0f / D) + EPS);
            f32x4* o = (f32x4*)(C.out + (size_t)m * D);
#ifdef PROBE_TW
            const float dlt = ((const float*)(C.ws + WS_CTL + 65536))[0];
#else
            const float dlt = 0.f;
#endif
#pragma unroll
            for (int j = 0; j < 4; ++j) o[lane + 64 * j] = (f32x4){bf_lo(h[u][j].x), bf_hi(h[u][j].x), bf_lo(h[u][j].y), bf_hi(h[u][j].y)} * rs * g[j] + dlt; } }
    }
}

#define XB_TMO      128
#define XB_XCNT(j)  (256  + 64 * (j))
#define XB_XSUB(j)  (1280 + 64 * (j))
#define XB_XGEN(j)  (2304 + 64 * (j))
#define XB_TOP      3328
#define XB_TOPGEN   3392
#define XCD_BAR_WORDS 3456
#define XB_SPIN_CAP (1u << 18)

__device__ __forceinline__ unsigned xb_ld(unsigned* p)              { return __hip_atomic_load(p, __ATOMIC_RELAXED, __HIP_MEMORY_SCOPE_AGENT); }
__device__ __forceinline__ unsigned xb_add(unsigned* p, unsigned v) { return __hip_atomic_fetch_add(p, v, __ATOMIC_RELAXED, __HIP_MEMORY_SCOPE_AGENT); }
__device__ __forceinline__ unsigned xb_xcc_id() { return (unsigned)__builtin_amdgcn_s_getreg((3 << 11) | 20) & 0xFu; }
#define XB_SPIN(cond, bar) do { unsigned _sp = 0; while (cond) { __builtin_amdgcn_s_sleep(1); \
    if ((++_sp & 255u) == 0u) { if (xb_ld(&(bar)[XB_TMO])) break; if (_sp > XB_SPIN_CAP) { atomicAdd(&(bar)[XB_TMO], 1u); break; } } } } while (0)

struct XcdBarrier {
    unsigned* bar; unsigned x;
    volatile LAS unsigned* st;
};

__device__ __forceinline__ XcdBarrier xcd_barrier_post(unsigned* bar, volatile LAS unsigned* st) {
    XcdBarrier b; b.bar = bar; b.x = xb_xcc_id(); b.st = st;
    if (threadIdx.x == 0) (void)xb_add(&bar[XB_XCNT(b.x)], 1u);
    return b;
}
__device__ __forceinline__ void xcd_barrier_complete(unsigned* bar, unsigned x, unsigned& nloc, unsigned& nx) {
    const unsigned G = gridDim.x * gridDim.y * gridDim.z;
    unsigned sum, cnt, mine, sp = 0u;
    for (;;) {
        sum = 0u; cnt = 0u; mine = 0u;
#pragma unroll
        for (unsigned j = 0; j < 16; ++j) { const unsigned c = xb_ld(&bar[XB_XCNT(j)]); sum += c; cnt += (c > 0u) ? 1u : 0u; mine = (j == x) ? c : mine; }
        if (sum == G) break;
        __builtin_amdgcn_s_sleep(1);
        if ((++sp & 255u) == 0u) { if (xb_ld(&bar[XB_TMO])) break; if (sp > XB_SPIN_CAP) { atomicAdd(&bar[XB_TMO], 1u); break; } }
    }
    nloc = mine > 0u ? mine : 1u; nx = cnt > 0u ? cnt : 1u;
}

__device__ __forceinline__ void xcd_barrier(const XcdBarrier& b) {
    asm volatile("s_waitcnt vmcnt(0)" ::: "memory");
    __syncthreads();
    if (threadIdx.x == 0) {
        unsigned* bar = b.bar;
        __builtin_amdgcn_s_waitcnt(0);
        unsigned nloc = b.st[0], nx = b.st[1];
        if (nloc == 0u) { xcd_barrier_complete(bar, b.x, nloc, nx); b.st[0] = nloc; b.st[1] = nx; }
        const unsigned old = xb_add(&bar[XB_XSUB(b.x)], 1u);
        const unsigned gen = old / nloc;
        if (old + 1u == (gen + 1u) * nloc) {
            __builtin_amdgcn_fence(__ATOMIC_RELEASE, "agent");
            asm volatile("s_waitcnt vmcnt(0)" ::: "memory");
            const unsigned og = xb_add(&bar[XB_TOP], 1u);
            const unsigned tg = og / nx;
            if (og + 1u == (tg + 1u) * nx) xb_add(&bar[XB_TOPGEN], 1u);
            else XB_SPIN(xb_ld(&bar[XB_TOPGEN]) == tg, bar);
            __builtin_amdgcn_fence(__ATOMIC_ACQUIRE, "agent");
            xb_add(&bar[XB_XGEN(b.x)], 1u);
            asm volatile("s_waitcnt vmcnt(0)" ::: "memory");
        } else {
            XB_SPIN(xb_ld(&bar[XB_XGEN(b.x)]) == gen, bar);
            __builtin_amdgcn_fence(__ATOMIC_ACQUIRE, "agent");
            asm volatile("s_waitcnt vmcnt(0)" ::: "memory");
        }
    }
    __syncthreads();
}

__device__ __forceinline__ void seam_signal(unsigned* cnt) {
    asm volatile("s_waitcnt vmcnt(0)" ::: "memory");
    __syncthreads();
    if (threadIdx.x == 0) { __builtin_amdgcn_fence(__ATOMIC_RELEASE, "agent"); asm volatile("s_waitcnt vmcnt(0)" ::: "memory"); __hip_atomic_fetch_add(cnt, 1u, __ATOMIC_RELAXED, __HIP_MEMORY_SCOPE_AGENT); }
}
__device__ __forceinline__ void seam_wait(unsigned* cnt, unsigned need) {
    if (threadIdx.x == 0) {
        unsigned sp = 0;
        while (__hip_atomic_load(cnt, __ATOMIC_RELAXED, __HIP_MEMORY_SCOPE_AGENT) < need) { __builtin_amdgcn_s_sleep(2); if (++sp > (1u << 20)) break; }
        __builtin_amdgcn_fence(__ATOMIC_ACQUIRE, "agent");
        asm volatile("s_waitcnt vmcnt(0)" ::: "memory");
    }
    __syncthreads();
}
__device__ __forceinline__ void final_norm_panel(const Ctx& C, int row0) {
    const int tid = pg8::opaque_tid(), lane = tid & 63, wave = tid >> 6;
    const float* part = (const float*)(C.ws + WS_PART);
    f32x4 g[4];
#pragma unroll
    for (int j = 0; j < 4; ++j) g[j] = ((const f32x4*)C.in[22])[lane + 64 * j];
#pragma unroll 1
    for (int i = 0; i < 2; ++i) {
        f32x4 s4[4]; u32x2 h[4][4];
#pragma unroll
        for (int u = 0; u < 4; ++u) { const int m = row0 + wave * 8 + i * 4 + u; const f32x4* pp = (const f32x4*)(part + (size_t)m * 16); s4[u] = (pp[0] + pp[1]) + (pp[2] + pp[3]);
            const u32x2* hr = (const u32x2*)((const bf16*)(C.ws + WS_HB) + (size_t)m * D);
#pragma unroll
            for (int j = 0; j < 4; ++j) h[u][j] = hr[lane + 64 * j]; }
#pragma unroll
        for (int u = 0; u < 4; ++u) { const int m = row0 + wave * 8 + i * 4 + u;
            const float rs = __builtin_amdgcn_rsqf(((s4[u].x + s4[u].y) + (s4[u].z + s4[u].w)) * (1.0f / D) + EPS);
            f32x4* o = (f32x4*)(C.out + (size_t)m * D);
#pragma unroll
            for (int j = 0; j < 4; ++j) o[lane + 64 * j] = (f32x4){bf_lo(h[u][j].x), bf_hi(h[u][j].x), bf_lo(h[u][j].y), bf_hi(h[u][j].y)} * rs * g[j]; }
    }
}

constexpr int N_PHASES = 2 + 6 * NLAYER;
struct Args { const float* in[23]; float* out; unsigned char* ws; int ph_lo, ph_hi; };
#ifndef PROBE_REP
#define PROBE_REP 0
#endif
__global__ void __launch_bounds__(NTHR) hymba_fwd(Args args) {
    extern __shared__ __attribute__((aligned(16))) unsigned char lds_raw[];
    LAS unsigned char* lds = (LAS unsigned char*)lds_raw;
    cg::grid_group grid = cg::this_grid();
    if (args.ph_hi < 0) grid.sync();
    { volatile LAS unsigned* st0 = (volatile LAS unsigned*)(lds + L_BARST); if (threadIdx.x < 16) st0[threadIdx.x] = 0u; }
    __syncthreads();
    XcdBarrier xbar = xcd_barrier_post((unsigned*)(args.ws + WS_CTL), (volatile LAS unsigned*)(lds + L_BARST));
    Ctx C;
#pragma unroll
    for (int i = 0; i < 23; ++i) C.in[i] = args.in[i];
    C.out = args.out; C.ws = args.ws;
    unsigned char* ws = args.ws;
    const int G = gridDim.x, bx = blockIdx.x;
    const bool grp = (G == 256);
    const int pmc = 8 * (bx % 8) + (bx / 8) % 8, kc = bx / 64;
    bf16* hb = (bf16*)(ws + WS_HB); float* part = (float*)(ws + WS_PART);
    for (int ph = args.ph_lo; ph < args.ph_hi; ++ph) {
        const bool fin = (ph == N_PHASES - 1);
        const int l = fin ? NLAYER - 1 : (ph - 1) / 6, k = fin ? 6 : (ph - 1) % 6;
        if (ph > args.ph_lo) {
            if (!grp || ph == 1 || k == 1 || k == 2) xcd_barrier(xbar);
            else if (k == 0) seam_wait(seam_cnt(ws, l - 1, 3, pmc), 4u);
            else if (k == 3) seam_wait(seam_cnt(ws, l, 0, pmc), 4u);
            else if (k == 4) seam_wait(seam_cnt(ws, l, 1, pmc), 4u);
            else if (k == 5) seam_wait(seam_cnt(ws, l, 2, pmc), 4u);
            else seam_wait(seam_cnt(ws, l, 3, pmc), 4u);
        }
        const int nrep = 1 + ((PROBE_REP >> (ph == 0 ? 0 : k + 1)) & 1);
        for (int rep = 0; rep < nrep; ++rep) {
#if defined(PROBE_ACQREP)
        if (rep > 0) { if (threadIdx.x == 0) { __builtin_amdgcn_fence(__ATOMIC_ACQUIRE, "agent"); asm volatile("s_waitcnt vmcnt(0)" ::: "memory"); } __syncthreads(); }
#elif defined(PROBE_RELREP)
        if (rep > 0) { if (threadIdx.x == 0) { __builtin_amdgcn_fence(__ATOMIC_RELEASE, "agent"); asm volatile("s_waitcnt vmcnt(0)" ::: "memory"); } __syncthreads(); }
#elif defined(PROBE_BARREP)
        if (rep > 0) xcd_barrier(xbar);
#endif
        if (ph == 0) { p0_prologue(C, lds, 0, grp ? 1 : NLAYER, 1, bx, G); continue; }
        if (fin) { if (grp) final_norm_panel(C, 256 * pmc + 64 * kc); else final_norm(C); continue; }
        if (k == 0) {
            const bf16* Wt = (const bf16*)(ws + WS_WIN) + (size_t)l * D * DIN;
            pg8::Gemm g{hb, Wt, MMAIN, DIN, D}; pg8::StaticOrder S; S.init(MMAIN, DIN, G, bx);
            EpiScale<false> E{(bf16*)C.out, DIN, part};
            pg8::gemm_phase<EpiScale<false>, pg8::StaticOrder, true, true>(lds, g, S, E);
            for (int t = G - 1 - bx; t < DIN / 64; t += G) {
                if (grp && l > 0) seam_wait(meta_cnt(ws, l - 1, 2), D / 64);
                skinny_task<0>(hb + (size_t)MMAIN * D, Wt, D, t, (bf16*)C.out, DIN, part, lds);
                if (grp) seam_signal(meta_cnt(ws, l, 3)); }
            if (grp && bx >= 192) {
                if (bx < 197) { seam_wait(meta_cnt(ws, l, 3), DIN / 64);
                    if (bx < 196) rg_item(C, l, 0, 0, NMETA, bx - 192, -1, lds); else convpool_item(C, l, 0, 0, NMETA, lds); }
                if (l + 1 < NLAYER && bx >= 197) p0_prologue(C, lds, l + 1, l + 2, 0, bx - 197, 59);
            }
        } else if (k == 1) {
            for (int r2 = 0; r2 <= ((PROBE_REP >> 8) & 1); ++r2)
            for (int it = bx; it < (grp ? 256 : 257); it += G) {
                if (it < 256) convpool_item(C, l, it >> 7, NMETA + 64 * (it & 127), 64, lds);
                else convpool_item(C, l, 0, 0, NMETA, lds);
            }
            for (int r2 = 0; r2 <= ((PROBE_REP >> 9) & 1); ++r2)
            for (int it = bx; it < (grp ? 256 : 260); it += G) {
                if (it < 256) rg_item(C, l, it >> 7, NMETA + 256 * ((it >> 2) & 31), 256, it & 3, (it >> 2) & 31, lds);
                else rg_item(C, l, 0, 0, NMETA, it - 256, -1, lds);
            }
        } else if (k == 2) {
            for (int it = bx; it < 256; it += G) { rg_fix_item(C, l, it >> 7, (it >> 2) & 31, it & 3, (bf16*)(ws + WS_Y)); if (grp) seam_signal(seam_cnt(ws, l, 0, it >> 2)); }
        } else if (k == 3) {
            const bf16* Wt = (const bf16*)(ws + WS_WOUT) + (size_t)l * D * D;
            pg8::Gemm g{(const bf16*)(ws + WS_Y), Wt, MMAIN, D, D}; pg8::StaticOrder S; S.init(MMAIN, D, G, bx);
            EpiResid E{hb, hb, part};
            pg8::gemm_phase<EpiResid, pg8::StaticOrder, true, true>(lds, g, S, E);
            if (grp) seam_signal(seam_cnt(ws, l, 1, pmc));
            if (l + 1 < NLAYER) for (int t = bx; t < D / 64; t += G) {
                skinny_task<2>((const bf16*)(ws + WS_Y) + (size_t)MMAIN * D, Wt, D, t, hb, D, part, lds);
                if (grp) seam_signal(meta_cnt(ws, l, 0)); }
        } else if (k == 4) {
            const bf16* Wt = (const bf16*)(ws + WS_WUP) + (size_t)l * D * DFF;
            pg8::Gemm g{hb, Wt, MMAIN, DFF, D}; pg8::StaticOrder S; S.init(MMAIN, DFF, G, bx);
            EpiScale<true> E{(bf16*)(ws + WS_HID), DFF, part};
            pg8::gemm_phase<EpiScale<true>, pg8::StaticOrder, true, true>(lds, g, S, E);
            if (grp && rep == nrep - 1) seam_signal(seam_cnt(ws, l, 2, pmc));
            if (l + 1 < NLAYER && rep == 0) for (int t = bx; t < DFF / 64; t += G) {
                if (grp) seam_wait(meta_cnt(ws, l, 0), D / 64);
                skinny_task<1>(hb + (size_t)MMAIN * D, Wt, D, t, (bf16*)(ws + WS_HID), DFF, part, lds);
                if (grp) seam_signal(meta_cnt(ws, l, 1)); }
        } else {
            const bf16* Wt = (const bf16*)(ws + WS_WDN) + (size_t)l * DFF * D;
            pg8::Gemm g{(const bf16*)(ws + WS_HID), Wt, MMAIN, D, DFF}; pg8::StaticOrder S; S.init(MMAIN, D, G, bx);
            EpiResid E{hb, hb, part};
            pg8::gemm_phase<EpiResid, pg8::StaticOrder, true, true>(lds, g, S, E);
            if (grp) seam_signal(seam_cnt(ws, l, 3, pmc));
            if (l + 1 < NLAYER) for (int t = bx - 16; t >= 0 && t < D / 64; t += G) {
                if (grp) seam_wait(meta_cnt(ws, l, 1), DFF / 64);
                skinny_task<2>((const bf16*)(ws + WS_HID) + (size_t)MMAIN * DFF, Wt, DFF, t, hb, D, part, lds);
                if (grp) seam_signal(meta_cnt(ws, l, 2)); }
        }
        }
    }
}

extern "C" void kernel_launch(void* const* d_in, const int* in_sizes, int n_in, void* d_out, int out_size, void* d_ws, size_t ws_size, hipStream_t stream) {
    static int grid = 0;
    if (grid == 0) {
        if (n_in != 23 || out_size != MMAIN * D || ws_size < WS_END) { fprintf(stderr, "kernel_launch: unexpected shapes (n_in %d out %d ws %zu)\n", n_in, out_size, ws_size); grid = -1; return; }
        int dev = 0, cus = 0, per_cu = 0;
        hipGetDevice(&dev); hipDeviceGetAttribute(&cus, hipDeviceAttributeMultiprocessorCount, dev);
        hipFuncSetAttribute((const void*)hymba_fwd, hipFuncAttributeMaxDynamicSharedMemorySize, LDS_BYTES);
        hipOccupancyMaxActiveBlocksPerMultiprocessor(&per_cu, (const void*)hymba_fwd, NTHR, LDS_BYTES);
        if (per_cu < 1) per_cu = 1;
        (void)hipGetLastError();
        grid = cus;
    }
    if (grid < 0) return;
    if (hipMemsetAsync((char*)d_ws + WS_CTL, 0, CTL_ZERO_BYTES, stream) != hipSuccess) { fprintf(stderr, "kernel_launch: memset failed\n"); return; }
    Args a{};
    for (int i = 0; i < 23; ++i) a.in[i] = (const float*)d_in[i];
    a.out = (float*)d_out; a.ws = (unsigned char*)d_ws; a.ph_lo = 0; a.ph_hi = N_PHASES;
    void* kargs[] = {&a};
    hipError_t e = hipLaunchCooperativeKernel((const void*)hymba_fwd, dim3(grid), dim3(NTHR), kargs, LDS_BYTES, stream);
    if (e != hipSuccess) fprintf(stderr, "kernel_launch: cooperative launch failed: %s (grid %d)\n", hipGetErrorString(e), grid);
}
```
